# Optimizing an MI355X kernel written in HIP

```python
import jax, jax.numpy as jnp
from jax import lax
import numpy as np

D_MODEL = 1024
BATCH = 8
SEQ = 4096
DEPTH = 2

PLE_DIM = 256
EPS = 1e-6

MLA_HEADS = 4
MLA_Q_RANK = 384
MLA_KV_RANK = 256
MLA_NOPE = 128
MLA_ROPE = 64
MLA_V = 128
MLA_WIDTH = MLA_HEADS * MLA_V
ROPE_THETA = 10000.0
Q_BLOCK = 128

GLA_HEADS = 4
GLA_DK = 64
GLA_DV = 128
GLA_WIDTH = GLA_HEADS * GLA_DV
GLA_GATE_RANK = 16
GLA_TAU = 16.0
GLA_CHUNK = 64

D_MIX = MLA_WIDTH + GLA_WIDTH

IN_SPLITS = (
    MLA_Q_RANK,
    MLA_KV_RANK,
    MLA_ROPE,
    MLA_WIDTH,
    GLA_HEADS * GLA_DK,
    GLA_HEADS * GLA_DK,
    GLA_WIDTH,
    GLA_GATE_RANK,
    GLA_GATE_RANK,
    GLA_WIDTH,
)
D_IN = sum(IN_SPLITS)

kernel_name = "hymba_mla_gla_bidir_encoder"


def rmsnorm(x, g):
    xf = x.astype(jnp.float32)
    y = xf * lax.rsqrt(jnp.mean(xf * xf, axis=-1, keepdims=True) + EPS)
    return (y * g.astype(jnp.float32)).astype(x.dtype)


def split_cols(u, sizes):
    out, start = [], 0
    for s in sizes:
        out.append(u[..., start:start + s])
        start += s
    return out


def apply_rope(x, pos):
    half = MLA_ROPE // 2
    inv = ROPE_THETA ** (-jnp.arange(half, dtype=jnp.float32) / half)
    ang = pos.astype(jnp.float32)[..., None] * inv
    cos, sin = jnp.cos(ang), jnp.sin(ang)
    if x.ndim == 4:
        cos, sin = cos[:, :, None, :], sin[:, :, None, :]
    xf = x.astype(jnp.float32)
    x1, x2 = xf[..., :half], xf[..., half:]
    return jnp.concatenate([x1 * cos - x2 * sin, x1 * sin + x2 * cos], axis=-1).astype(x.dtype)


def mla_branch(c_q, c_kv, k_rope, pos, q_norm, w_uq, kv_norm, w_ukv):
    B, S, _ = c_q.shape
    q = (rmsnorm(c_q, q_norm) @ w_uq).reshape(B, S, MLA_HEADS, MLA_NOPE + MLA_ROPE)
    q_nope = q[..., :MLA_NOPE]
    q_rope = apply_rope(q[..., MLA_NOPE:], pos)
    kv = (rmsnorm(c_kv, kv_norm) @ w_ukv).reshape(B, S, MLA_HEADS, MLA_NOPE + MLA_V)
    k_nope, v = kv[..., :MLA_NOPE], kv[..., MLA_NOPE:]
    k_r = apply_rope(k_rope, pos)
    scale = (MLA_NOPE + MLA_ROPE) ** -0.5
    nb = S // Q_BLOCK
    qn_b = q_nope.reshape(B, nb, Q_BLOCK, MLA_HEADS, MLA_NOPE).transpose(1, 0, 2, 3, 4)
    qr_b = q_rope.reshape(B, nb, Q_BLOCK, MLA_HEADS, MLA_ROPE).transpose(1, 0, 2, 3, 4)

    def block(args):
        qn, qr = args
        s = (jnp.einsum('bqhd,bkhd->bhqk', qn, k_nope)
             + jnp.einsum('bqhr,bkr->bhqk', qr, k_r))
        prob = jax.nn.softmax(s.astype(jnp.float32) * scale, axis=-1).astype(v.dtype)
        return jnp.einsum('bhqk,bkhd->bqhd', prob, v)

    o = lax.map(block, (qn_b, qr_b))
    return o.transpose(1, 0, 2, 3, 4).reshape(B, S, MLA_WIDTH)


def gla_chunked(q, k, v, log_a):
    B, S, H, DK = q.shape
    DV = v.shape[-1]
    C = GLA_CHUNK
    N = S // C

    def to_chunks(t):
        return t.astype(jnp.float32).reshape(B, N, C, H, -1).transpose(1, 0, 3, 2, 4)

    qc, kc, vc, gc = to_chunks(q), to_chunks(k), to_chunks(v), to_chunks(log_a)
    b = jnp.cumsum(gc, axis=-2)
    ref = b[..., C // 2 - 1:C // 2, :]
    q_in = qc * jnp.exp(b - ref)
    k_in = kc * jnp.exp(ref - b)
    mask = jnp.tril(jnp.ones((C, C), dtype=bool))
    A = jnp.where(mask, jnp.einsum('nbhid,nbhjd->nbhij', q_in, k_in), 0.0)
    o_intra = jnp.einsum('nbhij,nbhjv->nbhiv', A, vc)

    b_last = b[..., -1:, :]
    q_inter = qc * jnp.exp(b)
    k_state = kc * jnp.exp(b_last - b)
    decay = jnp.exp(b_last[..., 0, :])

    def step(state, inp):
        qi, ki, vi, di = inp
        o = jnp.einsum('bhid,bhdv->bhiv', qi, state)
        state = state * di[..., None] + jnp.einsum('bhjd,bhjv->bhdv', ki, vi)
        return state, o

    s0 = jnp.zeros((B, H, DK, DV), jnp.float32)
    _, o_inter = lax.scan(step, s0, (q_inter, k_state, vc, decay))
    o = o_intra + o_inter
    return o.transpose(1, 0, 3, 2, 4).reshape(B, S, H, DV).astype(v.dtype)


def gla_branch(q, k, v, lr_f, lr_b, w_g_f, b_g_f, w_g_b, b_g_b, out_norm):
    B, S, _ = q.shape
    q = (q * GLA_DK ** -0.5).reshape(B, S, GLA_HEADS, GLA_DK)
    k = k.reshape(B, S, GLA_HEADS, GLA_DK)
    v = v.reshape(B, S, GLA_HEADS, GLA_DV)
    la_f = (jax.nn.log_sigmoid((lr_f @ w_g_f + b_g_f).astype(jnp.float32)) / GLA_TAU)
    la_b = (jax.nn.log_sigmoid((lr_b @ w_g_b + b_g_b).astype(jnp.float32)) / GLA_TAU)
    la_f = la_f.reshape(B, S, GLA_HEADS, GLA_DK)
    la_b = la_b.reshape(B, S, GLA_HEADS, GLA_DK)
    o_f = gla_chunked(q, k, v, la_f)
    flip = lambda t: jnp.flip(t, axis=1)
    o_b = flip(gla_chunked(flip(q), flip(k), flip(v), flip(la_b)))
    o = rmsnorm(o_f + o_b, out_norm)
    return o.reshape(B, S, GLA_WIDTH)


def setup_inputs(seed: int = 0) -> dict:
    key = jax.random.key(seed)
    ks = jax.random.split(key, 24)
    nrm = lambda k, shape, fan_in: jax.random.normal(k, shape, jnp.float32) * fan_in ** -0.5
    gain = lambda k, shape: 1.0 + 0.02 * jax.random.normal(k, shape, jnp.float32)
    L = DEPTH
    x = jax.random.normal(ks[0], (BATCH, SEQ, D_MODEL), jnp.float32)
    p = jax.random.normal(ks[1], (DEPTH, BATCH, SEQ, PLE_DIM), jnp.float32)
    offs = jax.random.randint(ks[2], (BATCH, 1), 0, 1024, dtype=jnp.int32)
    positions = offs + jnp.arange(SEQ, dtype=jnp.int32)[None, :]
    return {
        "x": x,
        "p": p,
        "positions": positions,
        "ln_mix": gain(ks[3], (L, D_MODEL)),
        "w_in": nrm(ks[4], (L, D_MODEL, D_IN), D_MODEL),
        "mla_q_norm": gain(ks[5], (L, MLA_Q_RANK)),
        "w_uq": nrm(ks[6], (L, MLA_Q_RANK, MLA_HEADS * (MLA_NOPE + MLA_ROPE)), MLA_Q_RANK),
        "mla_kv_norm": gain(ks[7], (L, MLA_KV_RANK)),
        "w_ukv": nrm(ks[8], (L, MLA_KV_RANK, MLA_HEADS * (MLA_NOPE + MLA_V)), MLA_KV_RANK),
        "gla_w_gate_fwd": nrm(ks[9], (L, GLA_GATE_RANK, GLA_HEADS * GLA_DK), GLA_GATE_RANK),
        "gla_b_gate_fwd": 0.1 * jax.random.normal(ks[10], (L, GLA_HEADS * GLA_DK), jnp.float32),
        "gla_w_gate_bwd": nrm(ks[11], (L, GLA_GATE_RANK, GLA_HEADS * GLA_DK), GLA_GATE_RANK),
        "gla_b_gate_bwd": 0.1 * jax.random.normal(ks[12], (L, GLA_HEADS * GLA_DK), jnp.float32),
        "gla_out_norm": gain(ks[13], (L, GLA_DV)),
        "w_out": nrm(ks[14], (L, D_MIX, D_MODEL), D_MIX),
        "ple_norm": gain(ks[15], (L, D_MODEL)),
        "w_ple_gate": nrm(ks[16], (L, D_MODEL, D_MODEL), D_MODEL),
        "w_ple_proj": nrm(ks[17], (L, PLE_DIM, D_MODEL), PLE_DIM),
        "final_norm": gain(ks[18], (D_MODEL,)),
    }


def reference(x, p, positions, ln_mix, w_in, mla_q_norm, w_uq, mla_kv_norm, w_ukv,
              gla_w_gate_fwd, gla_b_gate_fwd, gla_w_gate_bwd, gla_b_gate_bwd,
              gla_out_norm, w_out, ple_norm, w_ple_gate, w_ple_proj, final_norm):
    h = x
    for i in range(DEPTH):
        u = rmsnorm(h, ln_mix[i]) @ w_in[i]
        (c_q, c_kv, k_rope, gate_a, gq, gk, gv, lr_f, lr_b, gate_g) = split_cols(u, IN_SPLITS)
        y_mla = mla_branch(c_q, c_kv, k_rope, positions,
                           mla_q_norm[i], w_uq[i], mla_kv_norm[i], w_ukv[i]) * jax.nn.silu(gate_a)
        y_gla = gla_branch(gq, gk, gv, lr_f, lr_b,
                           gla_w_gate_fwd[i], gla_b_gate_fwd[i],
                           gla_w_gate_bwd[i], gla_b_gate_bwd[i],
                           gla_out_norm[i]) * jax.nn.silu(gate_g)
        h = h + jnp.concatenate([y_mla, y_gla], axis=-1) @ w_out[i]
        gate = jax.nn.sigmoid(rmsnorm(h, ple_norm[i]) @ w_ple_gate[i])
        h = h + gate * (p[i] @ w_ple_proj[i])
    return rmsnorm(h, final_norm)
```

```cpp
#include <hip/hip_runtime.h>
#include <hip/hip_cooperative_groups.h>
#include <cstdio>
#include <cstdint>
namespace cg = cooperative_groups;

__device__ __forceinline__ int tid_now(int wid_s) { int l; asm volatile("v_mbcnt_lo_u32_b32 %0, -1, 0\n\tv_mbcnt_hi_u32_b32 %0, -1, %0" : "=v"(l)); return (wid_s << 6) | l; }
__device__ __forceinline__ float shx(float v, int lane, int mask) { return __builtin_bit_cast(float, __builtin_amdgcn_ds_bpermute((lane ^ mask) << 2, __builtin_bit_cast(int, v))); }
namespace pg8 {
#define PG8_LAS __attribute__((address_space(3)))
typedef unsigned short bf16_t;
typedef short bf16x8 __attribute__((ext_vector_type(8)));
typedef float f32x4 __attribute__((ext_vector_type(4)));
typedef unsigned u32x4 __attribute__((ext_vector_type(4)));
constexpr int BM = 256, BK = 64, HALF = 128, HTB = HALF * BK * 2  , STAGE_BYTES = 8 * HTB, NXCD = 8, WGM = 8;

__host__ __device__ __forceinline__ int lds_byte(int r, int c) { const int st = (r >> 4) * 2 + (c >> 5), rr = r & 15, cc = c & 31, ob = rr * 64 + cc * 2; return st * 1024 + (ob ^ (((ob >> 9) & 1) << 5)); }
__host__ __device__ __forceinline__ void stage_rc(int b, int& R, int& C) { const int st = b / 1024, sb = b % 1024, swz = sb ^ (((sb >> 9) & 1) << 5); R = (st >> 1) * 16 + swz / 64; C = (st & 1) * 32 + (swz % 64) / 2; }
__host__ __device__ __forceinline__ int perm32(int rho) { const int n = rho >> 4, i = rho & 15; return 8 * (i >> 2) + 4 * n + (i & 3); }

struct Unit { int pm, pn; };
struct Gemm { const bf16_t* A; const bf16_t* Bt; int M, N, K; };

struct StaticOrder {
    int nM, nN, nwg, G, c;
    __host__ __device__ void init(int M, int N, int G_, int c_) { nM = M / BM; nN = N / BM; nwg = nM * nN; G = G_; c = c_; }
    __host__ __device__ bool next(int i, Unit& u) const {
        const long L = (long)i * G + c; if (L >= nwg) return false;
        int wgid = (int)L; { const int q = nwg / NXCD, r = nwg % NXCD, xcd = wgid % NXCD, off = wgid / NXCD; wgid = (xcd < r ? xcd * (q + 1) : r * (q + 1) + (xcd - r) * q) + off; }
        const int nig = WGM * nN, gid = wgid / nig, fm = gid * WGM, gsz = (nM - fm) < WGM ? (nM - fm) : WGM;
        u.pm = fm + ((wgid % nig) % gsz); u.pn = (wgid % nig) / gsz; return true;
    }
    __device__ __forceinline__ void a_ready(const Unit&) const {}
    __device__ __forceinline__ void done(const Unit&) const {}
};
__device__ __forceinline__ unsigned cvt_pk_bf16(float lo, float hi) { unsigned r; asm volatile("v_cvt_pk_bf16_f32 %0, %1, %2" : "=v"(r) : "v"(lo), "v"(hi)); return r; }
template <class Epi, class Sched, bool ALIGN_EPI = false, bool SP2 = false>
__device__ __forceinline__ void gemm_phase(PG8_LAS unsigned char* lds, const Gemm g, const Sched& S, const Epi& E, int wid_s) {
    int widl_ = wid_s; asm volatile("" : "+s"(widl_));
    const int tid = tid_now(widl_), wid = widl_, lane = tid & 63, wr = wid >> 2, wc = wid & 3, fr = lane & 15, fq = lane >> 4;
    const int K = g.K, nt = K / BK;
    unsigned voffA[2], voffB[2];
#pragma unroll
    for (int i = 0; i < 2; ++i) { int R, C; stage_rc(tid * 16 + i * 8192, R, C); const int Rb = Epi::PERM ? ((R & ~31) + perm32(R & 31)) : R;
        voffA[i] = (unsigned)(R * K + C) * 2u; voffB[i] = (unsigned)(Rb * K + C) * 2u; }
    const size_t kstep = (size_t)(BK * 2);
    const size_t hstep = (size_t)HALF * K * 2;
    const size_t tstep = 2 * hstep;
    const unsigned ldsw = (unsigned)wid * 1024u;
    const int aoff = lds_byte(wr * 64 + fr, fq * 8), boff = lds_byte(wc * 32 + fr, fq * 8);
#define PG8_SA(b, h) (((b) * 2 + (h)) * HTB)
#define PG8_SB(b, h) ((4 + (b) * 2 + (h)) * HTB)
#define PG8_STAGE(bufoff, gbase, voff) do { _Pragma("unroll") for (int _i = 0; _i < 2; ++_i) \
        __builtin_amdgcn_global_load_lds((const unsigned*)((const char*)(gbase) + (voff)[_i]), (PG8_LAS unsigned*)(lds + (bufoff) + ldsw + _i * 8192), 16, 0, 0); } while (0)
#define PG8_LDA(dst, b, h) do { _Pragma("unroll") for (int m = 0; m < 4; ++m) _Pragma("unroll") for (int k = 0; k < 2; ++k) dst[m][k] = *(const PG8_LAS bf16x8*)(lds + PG8_SA(b, h) + aoff + m * 2048 + k * 1024); } while (0)
#define PG8_LDB(dst, b, h) do { _Pragma("unroll") for (int n = 0; n < 2; ++n) _Pragma("unroll") for (int k = 0; k < 2; ++k) dst[n][k] = *(const PG8_LAS bf16x8*)(lds + PG8_SB(b, h) + boff + n * 2048 + k * 1024); } while (0)
#define PG8_MMA(ai, bj, At, Bt) do { __builtin_amdgcn_s_setprio(1); _Pragma("unroll") for (int m = 0; m < 4; ++m) _Pragma("unroll") for (int n = 0; n < 2; ++n) _Pragma("unroll") for (int k = 0; k < 2; ++k) \
        acc[ai][bj][m][n] = __builtin_amdgcn_mfma_f32_16x16x32_bf16(Bt[n][k], At[m][k], acc[ai][bj][m][n], 0, 0, 0); __builtin_amdgcn_s_setprio(0); } while (0)
#define PG8_WAIT_V(n) asm volatile("s_waitcnt vmcnt(" #n ")" ::: "memory")
#define PG8_WAIT_L(n) asm volatile("s_waitcnt lgkmcnt(" #n ")" ::: "memory")
#define PG8_BAR __builtin_amdgcn_s_barrier()
#define PG8_SCHED __builtin_amdgcn_sched_barrier(0)
    Unit cur, nxt; int ui = 0;
    if (!S.next(0, cur)) return;
    f32x4 acc[2][2][4][2];
#pragma unroll
    for (int a = 0; a < 2; ++a)
#pragma unroll
        for (int b = 0; b < 2; ++b)
#pragma unroll
            for (int m = 0; m < 4; ++m)
#pragma unroll
                for (int n = 0; n < 2; ++n) acc[a][b][m][n] = (f32x4){0.f, 0.f, 0.f, 0.f};
    bf16x8 At[4][2], B0[2][2], B1[2][2];
    const char* cA = (const char*)g.A + (size_t)cur.pm * tstep; const char* cB = (const char*)g.Bt + (size_t)cur.pn * tstep;
    S.a_ready(cur);
    if constexpr (SP2) {
        PG8_STAGE(PG8_SB(0, 0), cB, voffB); PG8_STAGE(PG8_SB(0, 1), cB + hstep, voffB); PG8_STAGE(PG8_SA(0, 0), cA, voffA); PG8_STAGE(PG8_SA(0, 1), cA + hstep, voffA);
        if (wr == 1) PG8_BAR;
        PG8_WAIT_V(2); PG8_BAR;
        PG8_STAGE(PG8_SB(1, 0), cB + kstep, voffB); PG8_STAGE(PG8_SA(1, 0), cA + kstep, voffA); PG8_STAGE(PG8_SB(1, 1), cB + hstep + kstep, voffB);
        PG8_WAIT_V(6); PG8_BAR;
    } else {
        PG8_STAGE(PG8_SB(0, 0), cB, voffB); PG8_STAGE(PG8_SA(0, 0), cA, voffA); PG8_STAGE(PG8_SB(0, 1), cB + hstep, voffB); PG8_STAGE(PG8_SA(0, 1), cA + hstep, voffA);
        if (wr == 1) PG8_BAR;
        PG8_WAIT_V(4); PG8_BAR;
        PG8_STAGE(PG8_SB(1, 0), cB + kstep, voffB); PG8_STAGE(PG8_SA(1, 0), cA + kstep, voffA); PG8_STAGE(PG8_SB(1, 1), cB + hstep + kstep, voffB);
        PG8_WAIT_V(6); PG8_BAR;
    }
    for (;;) {
        const bool has_next = S.next(ui + 1, nxt);
        const char* nA = has_next ? (const char*)g.A + (size_t)nxt.pm * tstep : cA; const char* nB = has_next ? (const char*)g.Bt + (size_t)nxt.pn * tstep : cB;
        for (int t = 0; t < nt; t += 2) {
            const bool last = (t == nt - 2);
            const char* a1 = cA + (size_t)(t + 1) * kstep;
            const char* a2 = last ? nA : cA + (size_t)(t + 2) * kstep; const char* b2 = last ? nB : cB + (size_t)(t + 2) * kstep;
            const char* a3 = a2 + kstep; const char* b3 = b2 + kstep;
            if (last && has_next) S.a_ready(nxt);
            if constexpr (SP2) {
            PG8_LDB(B0, 0, 0); PG8_LDB(B1, 0, 1); PG8_SCHED; PG8_LDA(At, 0, 0); PG8_STAGE(PG8_SA(1, 1), a1 + hstep, voffA);
            PG8_WAIT_V(8); PG8_WAIT_L(0); PG8_BAR; PG8_MMA(0, 0, At, B0); PG8_MMA(0, 1, At, B1); PG8_BAR; PG8_SCHED;
            PG8_LDA(At, 0, 1); PG8_STAGE(PG8_SB(0, 0), b2, voffB); PG8_STAGE(PG8_SB(0, 1), b2 + hstep, voffB); PG8_STAGE(PG8_SA(0, 0), a2, voffA);
            PG8_WAIT_V(8); PG8_WAIT_L(0); PG8_BAR; PG8_MMA(1, 0, At, B0); PG8_MMA(1, 1, At, B1); PG8_BAR; PG8_SCHED;
            PG8_LDB(B0, 1, 0); PG8_LDB(B1, 1, 1); PG8_SCHED; PG8_LDA(At, 1, 0); PG8_STAGE(PG8_SA(0, 1), a2 + hstep, voffA);
            PG8_WAIT_V(8); PG8_WAIT_L(0); PG8_BAR; PG8_MMA(0, 0, At, B0); PG8_MMA(0, 1, At, B1); PG8_BAR; PG8_SCHED;
            PG8_LDA(At, 1, 1); PG8_STAGE(PG8_SB(1, 0), b3, voffB); PG8_STAGE(PG8_SB(1, 1), b3 + hstep, voffB); PG8_STAGE(PG8_SA(1, 0), a3, voffA);
            PG8_WAIT_V(8); PG8_WAIT_L(0); PG8_BAR; PG8_MMA(1, 0, At, B0); PG8_MMA(1, 1, At, B1); PG8_BAR; PG8_SCHED;
            } else {
            PG8_LDB(B0, 0, 0); PG8_SCHED; PG8_LDA(At, 0, 0); PG8_STAGE(PG8_SA(1, 1), a1 + hstep, voffA);
            PG8_WAIT_L(8); PG8_BAR; PG8_WAIT_L(0); PG8_MMA(0, 0, At, B0); PG8_BAR; PG8_SCHED;
            PG8_LDB(B1, 0, 1); PG8_STAGE(PG8_SB(0, 0), b2, voffB);
            PG8_BAR; PG8_WAIT_L(0); PG8_MMA(0, 1, At, B1); PG8_BAR;
            PG8_LDA(At, 0, 1); PG8_STAGE(PG8_SA(0, 0), a2, voffA);
            PG8_BAR; PG8_WAIT_L(0); PG8_MMA(1, 0, At, B0); PG8_BAR; PG8_SCHED;
            PG8_STAGE(PG8_SB(0, 1), b2 + hstep, voffB);
            PG8_WAIT_V(6); PG8_BAR; PG8_MMA(1, 1, At, B1); PG8_BAR;
            PG8_LDB(B0, 1, 0); PG8_SCHED; PG8_LDA(At, 1, 0); PG8_STAGE(PG8_SA(0, 1), a2 + hstep, voffA);
            PG8_WAIT_L(8); PG8_BAR; PG8_WAIT_L(0); PG8_MMA(0, 0, At, B0); PG8_BAR; PG8_SCHED;
            PG8_LDB(B1, 1, 1); PG8_STAGE(PG8_SB(1, 0), b3, voffB);
            PG8_BAR; PG8_WAIT_L(0); PG8_MMA(0, 1, At, B1); PG8_BAR;
            PG8_LDA(At, 1, 1); PG8_STAGE(PG8_SA(1, 0), a3, voffA);
            PG8_BAR; PG8_WAIT_L(0); PG8_MMA(1, 0, At, B0); PG8_BAR; PG8_SCHED;
            PG8_STAGE(PG8_SB(1, 1), b3 + hstep, voffB);
            PG8_WAIT_V(6); PG8_BAR; PG8_MMA(1, 1, At, B1); PG8_BAR;
            }
        }
        if constexpr (ALIGN_EPI) { if (wr == 0) PG8_BAR; }
        if constexpr (!Epi::AFTER_DRAIN) { E(acc, cur, wr, wc, fr, fq); S.done(cur); }
        if (!has_next) break;
#pragma unroll
        for (int a = 0; a < 2; ++a)
#pragma unroll
            for (int b = 0; b < 2; ++b)
#pragma unroll
                for (int m = 0; m < 4; ++m)
#pragma unroll
                    for (int n = 0; n < 2; ++n) acc[a][b][m][n] = (f32x4){0.f, 0.f, 0.f, 0.f};
        cur = nxt; cA = nA; cB = nB; ++ui;
        if constexpr (ALIGN_EPI) { if (wr == 1) PG8_BAR; }
    }
    PG8_WAIT_V(0);
    if constexpr (!ALIGN_EPI) { if (wr == 0) PG8_BAR; }
    PG8_BAR;
    if constexpr (Epi::AFTER_DRAIN) { E.fused(acc, cur, wr, wc, fr, fq, lds, wid, lane); S.done(cur); }
#undef PG8_SA
#undef PG8_SB
#undef PG8_STAGE
#undef PG8_LDA
#undef PG8_LDB
#undef PG8_MMA
#undef PG8_WAIT_V
#undef PG8_WAIT_L
#undef PG8_BAR
#undef PG8_SCHED
}
}

using pg8::bf16_t; using pg8::bf16x8; using pg8::f32x4; using pg8::u32x4; using pg8::cvt_pk_bf16;
typedef float f32x16 __attribute__((ext_vector_type(16)));
typedef short s16x4 __attribute__((ext_vector_type(4)));
typedef float f32x2 __attribute__((ext_vector_type(2)));
#define LAS3 __attribute__((address_space(3)))

constexpr int T = 32768, SEQ = 4096, DM = 1024, DIN = 2784, DINP = 2816;
constexpr float EPS = 1e-6f;
constexpr size_t MiB = 1u << 20;
constexpr size_t WS_W = 0, W_LSTRIDE = 12 * MiB, WO_IN = 0, WO_UQ = 6 * MiB, WO_UKV = 7 * MiB, WO_PP = 7 * MiB + 512 * 1024, WO_OUT = 8 * MiB, WO_PG = 10 * MiB;
constexpr size_t WS_ROPE = 24 * MiB, WS_SSA = 32 * MiB, WS_SSB = 34 * MiB, WS_SSC = 36 * MiB, WS_XBA = 40 * MiB, WS_PB = 104 * MiB;
constexpr size_t WS_CQ = 136 * MiB, WS_CKV = 160 * MiB, WS_OB = 136 * MiB  ;
constexpr size_t WS_GQ = 176 * MiB, WS_GK = 192 * MiB, WS_LR = 208 * MiB, WS_GV = 210 * MiB, WS_GA = 242 * MiB, WS_GG = 274 * MiB;
constexpr size_t WS_Q = 306 * MiB, WS_K = 354 * MiB, WS_V = 402 * MiB, WS_XBB = 306 * MiB  , WS_PP = 370 * MiB  ;
constexpr size_t WS_Y = 434 * MiB, WS_END = 498 * MiB;

struct Params {
    const float *x, *p; const int* pos;
    const float *ln_mix, *w_in, *q_norm, *w_uq, *kv_norm, *w_ukv, *wgf, *bgf, *wgb, *bgb, *gla_norm, *w_out, *ple_norm, *w_pg, *w_pp, *final_norm;
    float* out; unsigned char* ws;
};

__device__ __forceinline__ unsigned f2bf(float f) { unsigned u = __builtin_bit_cast(unsigned, f); return (u + 0x7fffu + ((u >> 16) & 1u)) >> 16; }
__device__ __forceinline__ float bf2f(unsigned short h) { return __builtin_bit_cast(float, (unsigned)h << 16); }
__device__ __forceinline__ u32x4 pack8(f32x4 a, f32x4 b) { u32x4 w; w.x = cvt_pk_bf16(a[0], a[1]); w.y = cvt_pk_bf16(a[2], a[3]); w.z = cvt_pk_bf16(b[0], b[1]); w.w = cvt_pk_bf16(b[2], b[3]); return w; }
__device__ __forceinline__ float dot4(f32x4 a) { return (a[0] * a[0] + a[1] * a[1]) + (a[2] * a[2] + a[3] * a[3]); }
__device__ __forceinline__ float sigmoidf_(float v) { return __builtin_amdgcn_rcpf(1.f + __expf(-v)); }
__device__ __forceinline__ f32x4 silu4(f32x4 v) { f32x4 o; o[0] = v[0] * sigmoidf_(v[0]); o[1] = v[1] * sigmoidf_(v[1]); o[2] = v[2] * sigmoidf_(v[2]); o[3] = v[3] * sigmoidf_(v[3]); return o; }

__device__ __forceinline__ int wmap(int mode, int n, float& sc) {
    sc = 1.f;
    if (mode == 0) return n;
    if (mode == 1) {
        if (n < 640) return n;
        if (n < 768) { const int w = n - 640; if (w < 64) { const int i = w >> 1, s = w & 1; return 640 + (s ? 32 + i : i); } if (w < 80) return 2240 + (w - 64); if (w < 96) return 2256 + (w - 80); return -1; }
        if (n < 1280) return 704 + (n - 768);
        if (n < 1536) { sc = 0.125f; return 1216 + (n - 1280); }
        if (n < 1792) return 1472 + (n - 1536);
        if (n < 2304) return 1728 + (n - 1792);
        return 2272 + (n - 2304);
    }
    if (mode == 2) {
        const int h = n / 192, j = n % 192; if (j < 128) return n; const int w = j - 128, i = w >> 1, s = w & 1; return h * 192 + 128 + (s ? 32 + i : i);
    }
    if (n < 512) { const int h = n >> 7, j = n & 127; return h * 256 + j; }
    { const int m = n - 512, h = m >> 7, j = m & 127; return h * 256 + 128 + j; }
}
__device__ __forceinline__ void conv_w(const float* __restrict__ src, int K, int Nsrc, bf16_t* __restrict__ dst, int Ndst, const float* __restrict__ gain, int mode, int gtid, int gsz) {
    const int total = Ndst * (K / 8);
    for (int idx = gtid; idx < total; idx += gsz) {
        const int n = idx % Ndst, k0 = (idx / Ndst) * 8; float sc; const int s = wmap(mode, n, sc);
        float v[8];
#pragma unroll
        for (int j = 0; j < 8; ++j) v[j] = (s >= 0) ? src[(size_t)(k0 + j) * Nsrc + s] * (gain ? gain[k0 + j] : 1.f) * sc : 0.f;
        u32x4 w; w.x = cvt_pk_bf16(v[0], v[1]); w.y = cvt_pk_bf16(v[2], v[3]); w.z = cvt_pk_bf16(v[4], v[5]); w.w = cvt_pk_bf16(v[6], v[7]);
        *(u32x4*)(dst + (size_t)n * K + k0) = w;
    }
}
__device__ __forceinline__ void conv_w_tiled(const float* __restrict__ src, int K, int Nsrc, bf16_t* __restrict__ dst, int Ndst, const float* __restrict__ gain, int mode, float* tile, int tid, int first, int stride) {
    const int ntn = Ndst >> 6, nt = ntn * (K >> 6);
    const int nn = tid & 63, kq = tid >> 6, nn2 = tid >> 3, kseg = tid & 7;
    for (int t = first; t < nt; t += stride) {
        const int n0 = (t % ntn) * 64, k0 = (t / ntn) * 64;
        float sc; const int sidx = wmap(mode, n0 + nn, sc);
        float v[8];
#pragma unroll
        for (int i = 0; i < 8; ++i) v[i] = (sidx >= 0) ? src[(size_t)(k0 + kq + 8 * i) * Nsrc + sidx] * sc : 0.f;
#pragma unroll
        for (int i = 0; i < 8; ++i) tile[(kq + 8 * i) * 65 + nn] = v[i];
        __syncthreads();
        float o[8];
#pragma unroll
        for (int j = 0; j < 8; ++j) o[j] = tile[(kseg * 8 + j) * 65 + nn2] * (gain ? gain[k0 + kseg * 8 + j] : 1.f);
        u32x4 w; w.x = cvt_pk_bf16(o[0], o[1]); w.y = cvt_pk_bf16(o[2], o[3]); w.z = cvt_pk_bf16(o[4], o[5]); w.w = cvt_pk_bf16(o[6], o[7]);
        *(u32x4*)(dst + (size_t)(n0 + nn2) * K + k0 + kseg * 8) = w;
        __syncthreads();
    }
}
__device__ __forceinline__ void conv_layer_weights(const Params& P, int l, float* tile, int tid, int first, int stride) {
    unsigned char* wb = P.ws + WS_W + l * W_LSTRIDE;
    conv_w_tiled(P.w_in + (size_t)l * DM * DIN, 1024, DIN, (bf16_t*)(wb + WO_IN), DINP, P.ln_mix + l * 1024, 1, tile, tid, first, stride);
    conv_w_tiled(P.w_uq + (size_t)l * 384 * 768, 384, 768, (bf16_t*)(wb + WO_UQ), 768, P.q_norm + l * 384, 2, tile, tid, first, stride);
    conv_w_tiled(P.w_ukv + (size_t)l * 256 * 1024, 256, 1024, (bf16_t*)(wb + WO_UKV), 1024, P.kv_norm + l * 256, 3, tile, tid, first, stride);
    conv_w_tiled(P.w_pp + (size_t)l * 256 * 1024, 256, 1024, (bf16_t*)(wb + WO_PP), 1024, nullptr, 0, tile, tid, first, stride);
    conv_w_tiled(P.w_out + (size_t)l * 1024 * 1024, 1024, 1024, (bf16_t*)(wb + WO_OUT), 1024, nullptr, 0, tile, tid, first, stride);
    conv_w_tiled(P.w_pg + (size_t)l * 1024 * 1024, 1024, 1024, (bf16_t*)(wb + WO_PG), 1024, P.ple_norm + l * 1024, 0, tile, tid, first, stride);
}
__device__ __forceinline__ void prologue(const Params& P, int wid_s, float* tile) {
    const int tid = tid_now(wid_s); const int gtid = blockIdx.x * 512 + tid, gsz = gridDim.x * 512;
    unsigned char* ws = P.ws;
    conv_layer_weights(P, 0, tile, tid, blockIdx.x, gridDim.x);
    { f32x2* R = (f32x2*)(ws + WS_ROPE);
      for (int i = gtid; i < T * 32; i += gsz) { const int row = i >> 5, k = i & 31; const float inv = powf(10000.f, -(float)k / 32.f); const float ang = (float)P.pos[row] * inv;
        double rev = (double)ang * 0.15915494309189535; rev -= floor(rev); const float rf = (float)rev;
        f32x2 cs; cs.x = __builtin_amdgcn_cosf(rf); cs.y = __builtin_amdgcn_sinf(rf); R[i] = cs; } }
    { bf16_t* XB = (bf16_t*)(ws + WS_XBA); float* SS = (float*)(ws + WS_SSA); const int lane = tid & 63, gw = gtid >> 6, nw = gsz >> 6;
      for (int row = gw; row < T; row += nw) { float sacc = 0.f; f32x4 va[2], vb[2];
#pragma unroll
        for (int it = 0; it < 2; ++it) { const int col = it * 512 + lane * 8; va[it] = *(const f32x4*)(P.x + (size_t)row * 1024 + col); vb[it] = *(const f32x4*)(P.x + (size_t)row * 1024 + col + 4); }
#pragma unroll
        for (int it = 0; it < 2; ++it) { const int col = it * 512 + lane * 8; sacc += dot4(va[it]) + dot4(vb[it]); *(u32x4*)(XB + (size_t)row * 1024 + col) = pack8(va[it], vb[it]); }
#pragma unroll
        for (int o = 32; o >= 1; o >>= 1) sacc += shx(sacc, lane, o);
        if (lane < 16) SS[(size_t)row * 16 + lane] = (lane == 0) ? sacc : 0.f; } }
}

#define GAS1 __attribute__((address_space(1)))
__device__ __forceinline__ void gst16(void* p, u32x4 v) { *(GAS1 u32x4*)p = v; }
__device__ __forceinline__ void gst16f(void* p, f32x4 v) { *(GAS1 f32x4*)p = v; }
__device__ __forceinline__ void gst4f(void* p, float v) { *(GAS1 float*)p = v; }
__device__ __forceinline__ f32x4 gld16f(const void* p) { return *(const GAS1 f32x4*)p; }
__device__ __forceinline__ u32x4 gld16(const void* p) { return *(const GAS1 u32x4*)p; }
__device__ __forceinline__ void unpack8(u32x4 w, f32x4& a, f32x4& b) {
    a[0] = __builtin_bit_cast(float, w.x << 16); a[1] = __builtin_bit_cast(float, w.x & 0xffff0000u); a[2] = __builtin_bit_cast(float, w.y << 16); a[3] = __builtin_bit_cast(float, w.y & 0xffff0000u);
    b[0] = __builtin_bit_cast(float, w.z << 16); b[1] = __builtin_bit_cast(float, w.z & 0xffff0000u); b[2] = __builtin_bit_cast(float, w.w << 16); b[3] = __builtin_bit_cast(float, w.w & 0xffff0000u);
}
__device__ __forceinline__ void row_rstd(float (&rs)[2][4], const float* __restrict__ Pp, int stride, int off, int np, float invdim, int row0, int fq, int ln_) {
    f32x4 v[2][4];
#pragma unroll
    for (int ai = 0; ai < 2; ++ai)
#pragma unroll
        for (int m = 0; m < 4; ++m) v[ai][m] = (4 * fq < np) ? gld16f(Pp + (size_t)(row0 + ai * 128 + m * 16) * stride + off + 4 * fq) : (f32x4){0.f, 0.f, 0.f, 0.f};
#pragma unroll
    for (int ai = 0; ai < 2; ++ai)
#pragma unroll
        for (int m = 0; m < 4; ++m) { float s = (v[ai][m][0] + v[ai][m][1]) + (v[ai][m][2] + v[ai][m][3]);
            s += shx(s, ln_, 16); s += shx(s, ln_, 32); rs[ai][m] = rsqrtf(s * invdim + EPS); }
}
__device__ __forceinline__ void rope8(f32x4& v0, f32x4& v1, const f32x2* __restrict__ rp) {
    const f32x4 c01 = gld16f(rp), c23 = gld16f(rp + 2);
    f32x4 o0, o1;
    o0[0] = v0[0] * c01[0] - v0[1] * c01[1]; o0[1] = v0[0] * c01[1] + v0[1] * c01[0];
    o0[2] = v0[2] * c01[2] - v0[3] * c01[3]; o0[3] = v0[2] * c01[3] + v0[3] * c01[2];
    o1[0] = v1[0] * c23[0] - v1[1] * c23[1]; o1[1] = v1[0] * c23[1] + v1[1] * c23[0];
    o1[2] = v1[2] * c23[2] - v1[3] * c23[3]; o1[3] = v1[2] * c23[3] + v1[3] * c23[2];
    v0 = o0; v1 = o1;
}
struct Epi1 {
    static constexpr bool PERM = true, AFTER_DRAIN = false;
    unsigned char* wsb;
    __device__ __forceinline__ void operator()(const f32x4 (&acc)[2][2][4][2], const pg8::Unit& u, int wr, int wc, int fr, int fq) const {
        const int ln_ = tid_now(0) & 63; fr = ln_ & 15; fq = ln_ >> 4;
        unsigned char* ws = wsb; asm volatile("" : "+s"(ws));
        const float* SS = (const float*)(ws + WS_SSA); const f32x2* rope = (const f32x2*)(ws + WS_ROPE); float* SSC = (float*)(ws + WS_SSC);
        bf16_t* CQ = (bf16_t*)(ws + WS_CQ); bf16_t* CKV = (bf16_t*)(ws + WS_CKV); bf16_t* K = (bf16_t*)(ws + WS_K); bf16_t* LR = (bf16_t*)(ws + WS_LR); bf16_t* GA = (bf16_t*)(ws + WS_GA);
        bf16_t* GQ = (bf16_t*)(ws + WS_GQ); bf16_t* GK = (bf16_t*)(ws + WS_GK); bf16_t* GV = (bf16_t*)(ws + WS_GV); bf16_t* GG = (bf16_t*)(ws + WS_GG);
        const int row0 = u.pm * 256 + wr * 64 + fr; float rs[2][4]; row_rstd(rs, SS, 16, 0, 16, 1.f / 1024.f, row0, fq, ln_);
        const int hc = wc * 32 + fq * 8;
#pragma unroll
        for (int bj = 0; bj < 2; ++bj) { const int hf = u.pn * 2 + bj;
#pragma unroll
            for (int ai = 0; ai < 2; ++ai)
#pragma unroll
                for (int m = 0; m < 4; ++m) { const size_t row = (size_t)(row0 + ai * 128 + m * 16); const float r = rs[ai][m];
                    f32x4 v0 = acc[ai][bj][m][0] * r, v1 = acc[ai][bj][m][1] * r;
                    if (hf < 5) { float ss = dot4(v0) + dot4(v1); ss += shx(ss, ln_, 16); ss += shx(ss, ln_, 32); const u32x4 w = pack8(v0, v1);
                        if (hf < 3) { gst16(CQ + row * 384 + hf * 128 + hc, w); if (fq == 0) gst4f(SSC + (row * 32 + hf * 4 + wc), ss); }
                        else { gst16(CKV + row * 256 + (hf - 3) * 128 + hc, w); if (fq == 0) gst4f(SSC + (row * 32 + 12 + (hf - 3) * 4 + wc), ss); } }
                    else if (hf == 5) {
                        if (wc < 2) { rope8(v0, v1, rope + row * 32 + (hc >> 1)); const u32x4 w = pack8(v0, v1);
#pragma unroll
                            for (int h = 0; h < 4; ++h) gst16(K + row * 768 + h * 192 + 128 + hc, w); }
                        else if (wc == 2) { gst16(LR + row * 32 + (hc - 64), pack8(v0, v1)); } }
                    else if (hf < 10) { gst16(GA + row * 512 + (hf - 6) * 128 + hc, pack8(silu4(v0), silu4(v1))); }
                    else if (hf < 12) { gst16(GQ + row * 256 + (hf - 10) * 128 + hc, pack8(v0, v1)); }
                    else if (hf < 14) { gst16(GK + row * 256 + (hf - 12) * 128 + hc, pack8(v0, v1)); }
                    else if (hf < 18) { gst16(GV + row * 512 + (hf - 14) * 128 + hc, pack8(v0, v1)); }
                    else { gst16(GG + row * 512 + (hf - 18) * 128 + hc, pack8(silu4(v0), silu4(v1))); }
                } }
    }
};
struct EpiQ {
    static constexpr bool PERM = true, AFTER_DRAIN = false;
    unsigned char* wsb;
    __device__ __forceinline__ void operator()(const f32x4 (&acc)[2][2][4][2], const pg8::Unit& u, int wr, int wc, int fr, int fq) const {
        const int ln_ = tid_now(0) & 63; fr = ln_ & 15; fq = ln_ >> 4;
        unsigned char* ws = wsb; asm volatile("" : "+s"(ws));
        const float* SSC = (const float*)(ws + WS_SSC); const f32x2* rope = (const f32x2*)(ws + WS_ROPE); bf16_t* Q = (bf16_t*)(ws + WS_Q);
        const int row0 = u.pm * 256 + wr * 64 + fr; float rs[2][4]; row_rstd(rs, SSC, 32, 0, 12, 1.f / 384.f, row0, fq, ln_);
        const int hc = wc * 32 + fq * 8;
#pragma unroll
        for (int bj = 0; bj < 2; ++bj) { const int hf = u.pn * 2 + bj, hm = hf % 3; const bool rw = (hm == 1 && wc < 2) || (hm == 2 && wc >= 2);
            const int col = hf * 128 + hc, i0 = ((col % 192) - 128) >> 1;
#pragma unroll
            for (int ai = 0; ai < 2; ++ai)
#pragma unroll
                for (int m = 0; m < 4; ++m) { const size_t row = (size_t)(row0 + ai * 128 + m * 16); const float r = rs[ai][m];
                    f32x4 v0 = acc[ai][bj][m][0] * r, v1 = acc[ai][bj][m][1] * r;
                    if (rw) rope8(v0, v1, rope + row * 32 + i0);
                    gst16(Q + row * 768 + col, pack8(v0, v1)); } }
    }
};
struct EpiKV {
    static constexpr bool PERM = true, AFTER_DRAIN = false;
    unsigned char* wsb;
    __device__ __forceinline__ void operator()(const f32x4 (&acc)[2][2][4][2], const pg8::Unit& u, int wr, int wc, int fr, int fq) const {
        const int ln_ = tid_now(0) & 63; fr = ln_ & 15; fq = ln_ >> 4;
        unsigned char* ws = wsb; asm volatile("" : "+s"(ws));
        const float* SSC = (const float*)(ws + WS_SSC); bf16_t* K = (bf16_t*)(ws + WS_K); bf16_t* V = (bf16_t*)(ws + WS_V);
        const int row0 = u.pm * 256 + wr * 64 + fr; float rs[2][4]; row_rstd(rs, SSC, 32, 12, 8, 1.f / 256.f, row0, fq, ln_);
        const int hc = wc * 32 + fq * 8;
#pragma unroll
        for (int bj = 0; bj < 2; ++bj) { const int hf = u.pn * 2 + bj;
#pragma unroll
            for (int ai = 0; ai < 2; ++ai)
#pragma unroll
                for (int m = 0; m < 4; ++m) { const size_t row = (size_t)(row0 + ai * 128 + m * 16); const float r = rs[ai][m];
                    const u32x4 w = pack8(acc[ai][bj][m][0] * r, acc[ai][bj][m][1] * r);
                    if (hf < 4) gst16(K + row * 768 + hf * 192 + hc, w); else gst16(V + row * 512 + (hf - 4) * 128 + hc, w); } }
    }
};
struct EpiOut {
    static constexpr bool PERM = true, AFTER_DRAIN = false;
    const float* HIN; unsigned char* wsb;
    template <bool F32IN> __device__ __forceinline__ void body(const f32x4 (&acc)[2][2][4][2], const pg8::Unit& u, int wr, int wc, int fr, int fq, int ln_, unsigned char* ws) const {
        bf16_t* XB = (bf16_t*)(ws + WS_XBB); const bf16_t* XA = (const bf16_t*)(ws + WS_XBA); float* SSo = (float*)(ws + WS_SSB);
        const int row0 = u.pm * 256 + wr * 64 + fr, hc = wc * 32 + fq * 8;
#pragma unroll
        for (int ai = 0; ai < 2; ++ai)
#pragma unroll
            for (int mp = 0; mp < 2; ++mp) {
                f32x4 ha[2][2], hb[2][2];
#pragma unroll
                for (int mm = 0; mm < 2; ++mm)
#pragma unroll
                    for (int bj = 0; bj < 2; ++bj) { const size_t o = (size_t)(row0 + ai * 128 + (mp * 2 + mm) * 16) * 1024 + u.pn * 256 + bj * 128 + hc;
                        if constexpr (F32IN) { ha[mm][bj] = gld16f(HIN + o); hb[mm][bj] = gld16f(HIN + o + 4); } else { ha[mm][bj] = __builtin_bit_cast(f32x4, gld16(XA + o)); } }
#pragma unroll
                for (int mm = 0; mm < 2; ++mm) { const int m = mp * 2 + mm; const size_t row = (size_t)(row0 + ai * 128 + m * 16); float ss = 0.f;
#pragma unroll
                    for (int bj = 0; bj < 2; ++bj) { const size_t o = row * 1024 + u.pn * 256 + bj * 128 + hc; f32x4 a, b;
                        if constexpr (F32IN) { a = ha[mm][bj]; b = hb[mm][bj]; } else unpack8(__builtin_bit_cast(u32x4, ha[mm][bj]), a, b);
                        const f32x4 v0 = acc[ai][bj][m][0] + a, v1 = acc[ai][bj][m][1] + b;
                        gst16(XB + o, pack8(v0, v1)); ss += dot4(v0) + dot4(v1); }
                    ss += shx(ss, ln_, 16); ss += shx(ss, ln_, 32); gst4f(SSo + (row * 16 + u.pn * 4 + wc), ss); }
            }
    }
    __device__ __forceinline__ void operator()(const f32x4 (&acc)[2][2][4][2], const pg8::Unit& u, int wr, int wc, int fr, int fq) const {
        const int ln_ = tid_now(0) & 63; fr = ln_ & 15; fq = ln_ >> 4;
        unsigned char* ws = wsb; asm volatile("" : "+s"(ws));
        if (HIN != nullptr) body<true>(acc, u, wr, wc, fr, fq, ln_, ws); else body<false>(acc, u, wr, wc, fr, fq, ln_, ws);
    }
};
struct EpiPP {
    static constexpr bool PERM = true, AFTER_DRAIN = false;
    bf16_t* PPd;
    __device__ __forceinline__ void operator()(const f32x4 (&acc)[2][2][4][2], const pg8::Unit& u, int wr, int wc, int fr, int fq) const {
        const int ln_ = tid_now(0) & 63; fr = ln_ & 15; fq = ln_ >> 4;
        bf16_t* PP = PPd; asm volatile("" : "+s"(PP));
        const int row0 = u.pm * 256 + wr * 64 + fr, hc = wc * 32 + fq * 8;
#pragma unroll
        for (int ai = 0; ai < 2; ++ai)
#pragma unroll
            for (int m = 0; m < 4; ++m)
#pragma unroll
                for (int bj = 0; bj < 2; ++bj) gst16(PP + (size_t)(row0 + ai * 128 + m * 16) * 1024 + u.pn * 256 + bj * 128 + hc, pack8(acc[ai][bj][m][0], acc[ai][bj][m][1]));
    }
};
struct EpiPle {
    static constexpr bool PERM = true, AFTER_DRAIN = false;
    const bf16_t* PPd; unsigned char* wsb;
    __device__ __forceinline__ void operator()(const f32x4 (&acc)[2][2][4][2], const pg8::Unit& u, int wr, int wc, int fr, int fq) const {
        const int ln_ = tid_now(0) & 63; fr = ln_ & 15; fq = ln_ >> 4;
        unsigned char* ws = wsb; asm volatile("" : "+s"(ws));
        const float* SSin = (const float*)(ws + WS_SSB); const bf16_t* PP = PPd; asm volatile("" : "+s"(PP)); const bf16_t* XH = (const bf16_t*)(ws + WS_XBB); bf16_t* XB = (bf16_t*)(ws + WS_XBA); float* SSo = (float*)(ws + WS_SSA);
        const int row0 = u.pm * 256 + wr * 64 + fr, hc = wc * 32 + fq * 8; float rs[2][4]; row_rstd(rs, SSin, 16, 0, 16, 1.f / 1024.f, row0, fq, ln_);
#pragma unroll
        for (int ai = 0; ai < 2; ++ai)
#pragma unroll
            for (int mp = 0; mp < 2; ++mp) {
                u32x4 pw[2][2], hw[2][2];
#pragma unroll
                for (int mm = 0; mm < 2; ++mm)
#pragma unroll
                    for (int bj = 0; bj < 2; ++bj) { const size_t o = (size_t)(row0 + ai * 128 + (mp * 2 + mm) * 16) * 1024 + u.pn * 256 + bj * 128 + hc; pw[mm][bj] = gld16(PP + o); hw[mm][bj] = gld16(XH + o); }
#pragma unroll
                for (int mm = 0; mm < 2; ++mm) { const int m = mp * 2 + mm; const size_t row = (size_t)(row0 + ai * 128 + m * 16); const float r = rs[ai][m]; float ss = 0.f;
#pragma unroll
                    for (int bj = 0; bj < 2; ++bj) { const size_t o = row * 1024 + u.pn * 256 + bj * 128 + hc;
                        f32x4 p0, p1, h0, h1; unpack8(pw[mm][bj], p0, p1); unpack8(hw[mm][bj], h0, h1);
                        const f32x4 a0 = acc[ai][bj][m][0] * r, a1 = acc[ai][bj][m][1] * r; f32x4 v0, v1;
#pragma unroll
                        for (int e = 0; e < 4; ++e) { v0[e] = h0[e] + sigmoidf_(a0[e]) * p0[e]; v1[e] = h1[e] + sigmoidf_(a1[e]) * p1[e]; }
                        gst16(XB + o, pack8(v0, v1));
                        ss += dot4(v0) + dot4(v1); }
                    ss += shx(ss, ln_, 16); ss += shx(ss, ln_, 32); gst4f(SSo + (row * 16 + u.pn * 4 + wc), ss); }
            }
    }
};
namespace att {
constexpr int NW = 8, QBLK = 32, KVBLK = 64, LDQ = 768, LDK = 768, LDV = 512;
constexpr float SCALE = 0.07216878364870322f;
constexpr float THR = 8.f;
constexpr int SHM_V = 64 * 128 * 2, SHM_K = 64 * 400, SHM_ATTN = 2 * SHM_V + 2 * SHM_K + NW * 64 * 4;
#define KSWZ(row, colB) ((row) * 400 + (colB))
#define SBAR() __builtin_amdgcn_sched_barrier(0)
__device__ __forceinline__ int crow(int r, int hi) { return (r & 3) + 8 * (r >> 2) + 4 * hi; }
__device__ __forceinline__ unsigned cvtpk(float lo, float hi) { unsigned r; asm volatile("v_cvt_pk_bf16_f32 %0, %1, %2" : "=v"(r) : "v"(lo), "v"(hi)); return r; }
__device__ __forceinline__ void partialSM(f32x16& p0, f32x16& p1, float& m_reg, float& mn, float& alpha) {
  constexpr float C = SCALE * 1.4426950408889634f;
  float pmax = p0[0];
#pragma unroll
  for (int r = 1; r < 16; ++r) pmax = fmaxf(pmax, p0[r]);
#pragma unroll
  for (int r = 0; r < 16; ++r) pmax = fmaxf(pmax, p1[r]);
  { auto rr = __builtin_amdgcn_permlane32_swap(__float_as_uint(pmax), __float_as_uint(pmax), false, false);
    pmax = fmaxf(__uint_as_float(rr[0]), __uint_as_float(rr[1])); }
  if (__builtin_expect(__all(pmax - m_reg <= THR / SCALE), 1)) { mn = m_reg; alpha = 1.f; }
  else { mn = fmaxf(m_reg, pmax); alpha = __builtin_amdgcn_exp2f((m_reg - mn) * C); m_reg = mn; }
  float mnC = -mn * C;
#pragma unroll
  for (int r = 0; r < 16; ++r) p0[r] = fmaf(p0[r], C, mnC);
#pragma unroll
  for (int r = 0; r < 16; ++r) p1[r] = fmaf(p1[r], C, mnC);
#pragma unroll
  for (int r = 0; r < 16; ++r) p0[r] = __builtin_amdgcn_exp2f(p0[r]);
}
__device__ __forceinline__ void finishSM(f32x16& p0, f32x16& p1, float alpha, float& l_reg, bf16x8& pa0, bf16x8& pa1, bf16x8& pa2, bf16x8& pa3) {
#pragma unroll
  for (int r = 0; r < 16; ++r) p1[r] = __builtin_amdgcn_exp2f(p1[r]);
  float ps = 0;
#pragma unroll
  for (int r = 0; r < 16; ++r) ps += p0[r];
#pragma unroll
  for (int r = 0; r < 16; ++r) ps += p1[r];
  { auto rr = __builtin_amdgcn_permlane32_swap(__float_as_uint(ps), __float_as_uint(ps), false, false);
    ps = __uint_as_float(rr[0]) + __uint_as_float(rr[1]); }
  l_reg = l_reg * alpha + ps;
#define PK4(P, BASE, OUT) do { unsigned a0 = cvtpk(P[BASE + 0], P[BASE + 1]), a1 = cvtpk(P[BASE + 2], P[BASE + 3]);   \
    unsigned b0 = cvtpk(P[BASE + 4], P[BASE + 5]), b1 = cvtpk(P[BASE + 6], P[BASE + 7]);                              \
    auto r0 = __builtin_amdgcn_permlane32_swap(a0, b0, false, false); auto r1 = __builtin_amdgcn_permlane32_swap(a1, b1, false, false); \
    u32x4 w = {r0[0], r1[0], r0[1], r1[1]}; OUT = *reinterpret_cast<bf16x8*>(&w); } while (0)
  PK4(p0, 0, pa0); PK4(p0, 8, pa1); PK4(p1, 0, pa2); PK4(p1, 8, pa3);
#undef PK4
}
__device__ __forceinline__ void qkt(f32x16& p0, f32x16& p1, const char* Ks, const bf16x8* qr, int r32, int hi) {
  p0 = f32x16{}; p1 = f32x16{};
  const char* kb_ = Ks + r32 * 400 + hi * 16;
#pragma unroll
  for (int d0 = 0; d0 < 12; ++d0) {
    bf16x8 b0 = *reinterpret_cast<const bf16x8*>(kb_ + d0 * 32);
    bf16x8 b1 = *reinterpret_cast<const bf16x8*>(kb_ + 32 * 400 + d0 * 32);
    p0 = __builtin_amdgcn_mfma_f32_32x32x16_bf16(b0, qr[d0], p0, 0, 0, 0);
    p1 = __builtin_amdgcn_mfma_f32_32x32x16_bf16(b1, qr[d0], p1, 0, 0, 0); }
}
__device__ __forceinline__ int v_st(int k, int c) { const int kk = (k & ~0xC) | ((k & 4) << 1) | ((k & 8) >> 1); return ((kk >> 3) * 4 + (c >> 5)) * 512 + ((kk & 7) * 32 + (c & 31)) * 2; }
__device__ __forceinline__ int v_rd_base(int lane) { return ((lane & 3) << 3) | (((lane >> 2) & 3) << 6) | (((lane >> 4) & 1) << 5) | (((lane >> 5) & 1) << 8); }
constexpr int v_rd_off(int d0, int ks, int half) { return d0 * 512 + ks * 4096 + half * 2048; }
template <int OFF> __device__ __forceinline__ s16x4 tr_read(int vb) {
  s16x4 r; asm volatile("ds_read_b64_tr_b16 %0, %1 offset:%2" : "=&v"(r) : "v"(vb), "i"(OFF) : "memory"); return r;
}
template <int D0> __device__ __forceinline__ void pv_one(f32x16& od, int vb, bf16x8 pa0, bf16x8 pa1, bf16x8 pa2, bf16x8 pa3) {
  const s16x4 l0 = tr_read<v_rd_off(D0, 0, 0)>(vb), h0 = tr_read<v_rd_off(D0, 0, 1)>(vb), l1 = tr_read<v_rd_off(D0, 1, 0)>(vb), h1 = tr_read<v_rd_off(D0, 1, 1)>(vb);
  const s16x4 l2 = tr_read<v_rd_off(D0, 2, 0)>(vb), h2 = tr_read<v_rd_off(D0, 2, 1)>(vb), l3 = tr_read<v_rd_off(D0, 3, 0)>(vb), h3 = tr_read<v_rd_off(D0, 3, 1)>(vb);
  asm volatile("s_waitcnt lgkmcnt(0)" ::: "memory"); SBAR();
#define PK(L, H) (bf16x8){L[0], L[1], L[2], L[3], H[0], H[1], H[2], H[3]}
  od = __builtin_amdgcn_mfma_f32_32x32x16_bf16(pa0, PK(l0, h0), od, 0, 0, 0);
  od = __builtin_amdgcn_mfma_f32_32x32x16_bf16(pa1, PK(l1, h1), od, 0, 0, 0);
  od = __builtin_amdgcn_mfma_f32_32x32x16_bf16(pa2, PK(l2, h2), od, 0, 0, 0);
  od = __builtin_amdgcn_mfma_f32_32x32x16_bf16(pa3, PK(l3, h3), od, 0, 0, 0);
#undef PK
}
__device__ __forceinline__ void pv_d0(f32x16* o, int vb, bf16x8 pa0, bf16x8 pa1, bf16x8 pa2, bf16x8 pa3) {
  pv_one<0>(o[0], vb, pa0, pa1, pa2, pa3); pv_one<1>(o[1], vb, pa0, pa1, pa2, pa3); pv_one<2>(o[2], vb, pa0, pa1, pa2, pa3); pv_one<3>(o[3], vb, pa0, pa1, pa2, pa3);
}
__device__ __forceinline__ void attn_unit(const bf16_t* __restrict__ Qb, const bf16_t* __restrict__ Kh, const bf16_t* __restrict__ Vh,
                                          const bf16_t* __restrict__ Gb, bf16_t* __restrict__ Ob, int seq, char* lds, int wid_s) {
  const int tid = tid_now(wid_s), wid = tid >> 6, lane = tid & 63, r32 = lane & 31, hi = lane >> 5;
  char* V_lds = lds; char* K_lds = lds + 2 * SHM_V;
  float* ws = (float*)(lds + 2 * SHM_V + 2 * SHM_K) + wid * 64; float* li_l = ws; float* al_l = ws + 32;
  float m_reg = -1e30f, l_reg = 0; f32x16 o[4] = {}; bf16x8 qr[12];
  const bf16_t* Qw = Qb + (size_t)(wid * QBLK + r32) * LDQ + hi * 8;
#pragma unroll
  for (int d0 = 0; d0 < 12; ++d0) qr[d0] = *(const bf16x8*)(Qw + d0 * 16);
  const int sr = tid >> 4, sc = (tid & 15) * 8, vst0 = v_st(sr, sc), vst1 = v_st(32 + sr, sc);
  const int kc0 = tid, kc1 = tid + 512, kc2 = tid + 1024;
  const int kr0 = kc0 / 24, kr1 = kc1 / 24, kr2 = kc2 / 24, kq0 = (kc0 % 24) * 8, kq1 = (kc1 % 24) * 8, kq2 = (kc2 % 24) * 8;
  const int kst0 = KSWZ(kr0, kq0 * 2), kst1 = KSWZ(kr1, kq1 * 2), kst2 = KSWZ(kr2, kq2 * 2);
  const int kg0 = kr0 * LDK + kq0, kg1 = kr1 * LDK + kq1, kg2 = kr2 * LDK + kq2;
  const int vb0 = (int)(uintptr_t)V_lds + v_rd_base(lane);
  bf16x8 vs0, vs1, ks0, ks1, ks2;
#define SLOAD(k0) do { vs0 = *(const bf16x8*)(Vh + (size_t)((k0) + sr) * LDV + sc); vs1 = *(const bf16x8*)(Vh + (size_t)((k0) + 32 + sr) * LDV + sc); \
    const bf16_t* kp_ = Kh + (size_t)(k0) * LDK; ks0 = *(const bf16x8*)(kp_ + kg0); ks1 = *(const bf16x8*)(kp_ + kg1); ks2 = *(const bf16x8*)(kp_ + kg2); } while (0)
#define SWRITE(b) do { *(bf16x8*)(V_lds + (b) * SHM_V + vst0) = vs0; *(bf16x8*)(V_lds + (b) * SHM_V + vst1) = vs1; \
    *(bf16x8*)(K_lds + (b) * SHM_K + kst0) = ks0; *(bf16x8*)(K_lds + (b) * SHM_K + kst1) = ks1; *(bf16x8*)(K_lds + (b) * SHM_K + kst2) = ks2; } while (0)
#define SWAIT() asm volatile("s_waitcnt vmcnt(0)" ::: "memory")
#define RESC(a) do { if (__any((a) < 1.f)) { if (hi == 0) al_l[r32] = (a); asm volatile("s_waitcnt lgkmcnt(0)" ::: "memory"); \
    _Pragma("unroll") for (int d = 0; d < 4; ++d) _Pragma("unroll") for (int r = 0; r < 16; ++r) o[d][r] *= al_l[crow(r, hi)]; } } while (0)
  f32x16 pA0, pA1, pB0, pB1; float mnA, mnB, alA, alB; bf16x8 pa0, pa1, pa2, pa3; const int NT = seq / KVBLK;
  SLOAD(0); SWAIT(); SWRITE(0); __syncthreads();
  qkt(pA0, pA1, K_lds, qr, r32, hi); partialSM(pA0, pA1, m_reg, mnA, alA);
  SLOAD(KVBLK); SWAIT(); SWRITE(1); __syncthreads();
  for (int j = 1; j + 1 < NT; j += 2) {
    SBAR(); qkt(pB0, pB1, K_lds + SHM_K, qr, r32, hi);
    finishSM(pA0, pA1, alA, l_reg, pa0, pa1, pa2, pa3); SBAR();
    SLOAD((j + 1) * KVBLK); SBAR();
    pv_d0(o, vb0, pa0, pa1, pa2, pa3); partialSM(pB0, pB1, m_reg, mnB, alB);
    __syncthreads(); SWAIT(); SWRITE(0);
    RESC(alB); __syncthreads();
    SBAR(); qkt(pA0, pA1, K_lds, qr, r32, hi);
    finishSM(pB0, pB1, alB, l_reg, pa0, pa1, pa2, pa3); SBAR();
    SLOAD((j + 2) * KVBLK); SBAR();
    pv_d0(o, vb0 + SHM_V, pa0, pa1, pa2, pa3); partialSM(pA0, pA1, m_reg, mnA, alA);
    __syncthreads(); SWAIT(); SWRITE(1);
    RESC(alA); __syncthreads();
  }
  SBAR(); qkt(pB0, pB1, K_lds + SHM_K, qr, r32, hi);
  finishSM(pA0, pA1, alA, l_reg, pa0, pa1, pa2, pa3); SBAR();
  pv_d0(o, vb0, pa0, pa1, pa2, pa3); partialSM(pB0, pB1, m_reg, mnB, alB);
  __syncthreads(); RESC(alB);
  finishSM(pB0, pB1, alB, l_reg, pa0, pa1, pa2, pa3); SBAR();
  pv_d0(o, vb0 + SHM_V, pa0, pa1, pa2, pa3);
  if (hi == 0) li_l[r32] = l_reg; asm volatile("s_waitcnt lgkmcnt(0)" ::: "memory");
  float rli[16];
#pragma unroll
  for (int r = 0; r < 16; ++r) rli[r] = __builtin_amdgcn_rcpf(li_l[crow(r, hi)]);
  { bf16_t* ost = (bf16_t*)(lds + 92160) + wid * (32 * 136);
#pragma unroll
    for (int r = 0; r < 16; ++r)
#pragma unroll
      for (int d0 = 0; d0 < 4; ++d0) ost[crow(r, hi) * 136 + d0 * 32 + r32] = (bf16_t)f2bf(o[d0][r] * rli[r]);
    asm volatile("s_waitcnt lgkmcnt(0)" ::: "memory");
#pragma unroll
    for (int j = 0; j < 8; ++j) { const int chunk = j * 64 + lane, row = chunk >> 4, c8 = (chunk & 15) * 8;
      const bf16x8 v = *(const bf16x8*)(ost + row * 136 + c8); const bf16x8 g = *(const bf16x8*)(Gb + (size_t)(wid * QBLK + row) * 512 + c8);
      u32x4 w; w.x = cvtpk(bf2f((unsigned short)v[0]) * bf2f((unsigned short)g[0]), bf2f((unsigned short)v[1]) * bf2f((unsigned short)g[1]));
      w.y = cvtpk(bf2f((unsigned short)v[2]) * bf2f((unsigned short)g[2]), bf2f((unsigned short)v[3]) * bf2f((unsigned short)g[3]));
      w.z = cvtpk(bf2f((unsigned short)v[4]) * bf2f((unsigned short)g[4]), bf2f((unsigned short)v[5]) * bf2f((unsigned short)g[5]));
      w.w = cvtpk(bf2f((unsigned short)v[6]) * bf2f((unsigned short)g[6]), bf2f((unsigned short)v[7]) * bf2f((unsigned short)g[7]));
      *(u32x4*)(Ob + (size_t)(wid * QBLK + row) * 1024 + c8) = w; } }
  __syncthreads();
#undef SLOAD
#undef SWRITE
#undef SWAIT
#undef RESC
}
}

namespace gla {
constexpr int LS = 72;
constexpr int O_QS = 0, O_KS = 8192, O_LR = 16384, O_TOT = 18432, O_DEC = 20480, O_QIN = 20736, O_KIN = O_QIN + 9216, O_QINTER = O_KIN + 9216, O_KST = O_QINTER + 9216,
              O_AM = O_KST + 9216, O_ST = O_AM + 9216, O_VT = O_ST + 18432, O_OUTS = O_VT + 18432, LDS_END = O_OUTS + 64 * 136 * 2;
__device__ __forceinline__ f32x4 mma16(const bf16_t* Ap, const bf16_t* Bp, f32x4 acc) {
    acc = __builtin_amdgcn_mfma_f32_16x16x32_bf16(*(const bf16x8*)Ap, *(const bf16x8*)Bp, acc, 0, 0, 0);
    acc = __builtin_amdgcn_mfma_f32_16x16x32_bf16(*(const bf16x8*)(Ap + 32), *(const bf16x8*)(Bp + 32), acc, 0, 0, 0);
    return acc;
}
__device__ __forceinline__ void stream(const Params& P, int layer, int sid, char* lds, int wid_s) {
    const int b = sid >> 3, h = (sid >> 1) & 3, dir = sid & 1;
    const int tid = tid_now(wid_s), lane = tid & 63, w = tid >> 6, d = lane, g = w, fr = lane & 15, fq = lane >> 4;
    unsigned char* ws = P.ws;
    const bf16_t* GQ = (const bf16_t*)(ws + WS_GQ) + h * 64; const bf16_t* GK = (const bf16_t*)(ws + WS_GK) + h * 64; const bf16_t* GV = (const bf16_t*)(ws + WS_GV) + h * 128;
    const bf16_t* LR = (const bf16_t*)(ws + WS_LR) + dir * 16;
    bf16_t* OUT = dir ? (bf16_t*)(ws + WS_OB) + h * 128 : (bf16_t*)(ws + WS_Y) + 512 + h * 128; const int ostride = dir ? 512 : 1024;
    float wreg[16];
    { const float* wg = (dir ? P.wgb : P.wgf) + layer * 16 * 256 + h * 64 + d;
#pragma unroll
      for (int r = 0; r < 16; ++r) wreg[r] = wg[r * 256]; }
    const float bias = (dir ? P.bgb : P.bgf)[layer * 256 + h * 64 + d];
    bf16_t* Qs = (bf16_t*)(lds + O_QS); bf16_t* Ks = (bf16_t*)(lds + O_KS); bf16_t* LRs = (bf16_t*)(lds + O_LR); float* TOT = (float*)(lds + O_TOT); float* DEC = (float*)(lds + O_DEC);
    bf16_t* QIN = (bf16_t*)(lds + O_QIN); bf16_t* KIN = (bf16_t*)(lds + O_KIN); bf16_t* QINTER = (bf16_t*)(lds + O_QINTER); bf16_t* KST = (bf16_t*)(lds + O_KST);
    bf16_t* AM = (bf16_t*)(lds + O_AM); bf16_t* ST = (bf16_t*)(lds + O_ST); bf16_t* VT = (bf16_t*)(lds + O_VT); bf16_t* OUTS = (bf16_t*)(lds + O_OUTS);
    f32x4 st[4];
#pragma unroll
    for (int m = 0; m < 4; ++m) st[m] = (f32x4){0.f, 0.f, 0.f, 0.f};
    const int qtok = tid >> 3, qc8 = tid & 7, vtok = tid & 63, vc8 = tid >> 6, ltok = tid >> 1, lhalf = tid & 1;
    const size_t tb = (size_t)b * SEQ;
#define ACT(step, tokp) (tb + (dir ? (63 - (step)) * 64 + (63 - (tokp)) : (step) * 64 + (tokp)))
    bf16x8 rq, rk, rv0, rv1, rl;
#define PREFETCH(step) do { const size_t tq_ = ACT(step, qtok), tv_ = ACT(step, vtok); \
        rq = *(const bf16x8*)(GQ + tq_ * 256 + qc8 * 8); rk = *(const bf16x8*)(GK + tq_ * 256 + qc8 * 8); \
        rv0 = *(const bf16x8*)(GV + tv_ * 512 + vc8 * 8); rv1 = *(const bf16x8*)(GV + tv_ * 512 + 64 + vc8 * 8); \
        if (tid < 128) rl = *(const bf16x8*)(LR + ACT(step, ltok) * 32 + lhalf * 8); } while (0)
    PREFETCH(0);
    for (int step = 0; step < 64; ++step) {
        *(bf16x8*)(Qs + qtok * 64 + qc8 * 8) = rq; *(bf16x8*)(Ks + qtok * 64 + qc8 * 8) = rk;
        if (tid < 128) *(bf16x8*)(LRs + ltok * 16 + lhalf * 8) = rl;
#pragma unroll
        for (int e = 0; e < 8; ++e) { VT[(vc8 * 8 + e) * LS + vtok] = (bf16_t)rv0[e]; VT[(64 + vc8 * 8 + e) * LS + vtok] = (bf16_t)rv1[e]; }
        __syncthreads();
        if (step + 1 < 64) PREFETCH(step + 1);
        float bb[8];
#pragma unroll
        for (int j = 0; j < 8; ++j) { const bf16x8 l0 = *(const bf16x8*)(LRs + (8 * g + j) * 16), l1 = *(const bf16x8*)(LRs + (8 * g + j) * 16 + 8); float z = bias;
#pragma unroll
            for (int r = 0; r < 8; ++r) { z = fmaf(bf2f((unsigned short)l0[r]), wreg[r], z); z = fmaf(bf2f((unsigned short)l1[r]), wreg[8 + r], z); }
            const float ls = fminf(z, 0.f) - __logf(1.f + __expf(-fabsf(z))); bb[j] = ls * (1.f / 16.f); }
#pragma unroll
        for (int j = 1; j < 8; ++j) bb[j] += bb[j - 1];
        TOT[g * 64 + d] = bb[7];
        __syncthreads();
        float pre = 0.f, ref = 0.f, blast = 0.f;
#pragma unroll
        for (int k = 0; k < 8; ++k) { const float t = TOT[k * 64 + d]; if (k < g) pre += t; if (k < 4) ref += t; blast += t; }
        { float kst[8];
#pragma unroll
          for (int j = 0; j < 8; ++j) { const float bj = pre + bb[j]; const int tok = 8 * g + j; const float q = bf2f(Qs[tok * 64 + d]), k = bf2f(Ks[tok * 64 + d]);
              QIN[tok * LS + d] = (bf16_t)f2bf(q * __expf(bj - ref)); KIN[tok * LS + d] = (bf16_t)f2bf(k * __expf(ref - bj)); QINTER[tok * LS + d] = (bf16_t)f2bf(q * __expf(bj));
              kst[j] = k * __expf(blast - bj); }
          u32x4 kw; kw.x = cvt_pk_bf16(kst[0], kst[1]); kw.y = cvt_pk_bf16(kst[2], kst[3]); kw.z = cvt_pk_bf16(kst[4], kst[5]); kw.w = cvt_pk_bf16(kst[6], kst[7]);
          *(u32x4*)(KST + d * LS + 8 * g) = kw; }
        if (g == 0) DEC[d] = __expf(blast);
#pragma unroll
        for (int m = 0; m < 4; ++m) { f32x2 sw; ((unsigned*)&sw)[0] = cvt_pk_bf16(st[m][0], st[m][1]); ((unsigned*)&sw)[1] = cvt_pk_bf16(st[m][2], st[m][3]);
            *(f32x2*)(ST + (16 * w + fr) * LS + 16 * m + 4 * fq) = sw; }
        __syncthreads();
#pragma unroll
        for (int e = 0; e < 2; ++e) { const int tile = 2 * w + e, mi = tile >> 2, nj = tile & 3;
            f32x4 a = mma16(QIN + (16 * mi + fr) * LS + fq * 8, KIN + (16 * nj + fr) * LS + fq * 8, (f32x4){0.f, 0.f, 0.f, 0.f});
#pragma unroll
            for (int jj = 0; jj < 4; ++jj) { const int i = 16 * mi + 4 * fq + jj, j = 16 * nj + fr; AM[i * LS + j] = (bf16_t)f2bf(j <= i ? a[jj] : 0.f); } }
        f32x4 oacc[4];
#pragma unroll
        for (int m = 0; m < 4; ++m) oacc[m] = mma16(QINTER + (16 * m + fr) * LS + fq * 8, ST + (16 * w + fr) * LS + fq * 8, (f32x4){0.f, 0.f, 0.f, 0.f});
#pragma unroll
        for (int m = 0; m < 4; ++m) { const f32x4 dc = *(const f32x4*)(DEC + 16 * m + 4 * fq); st[m] = mma16(KST + (16 * m + fr) * LS + fq * 8, VT + (16 * w + fr) * LS + fq * 8, st[m] * dc); }
        __syncthreads();
#pragma unroll
        for (int m = 0; m < 4; ++m) { oacc[m] = mma16(AM + (16 * m + fr) * LS + fq * 8, VT + (16 * w + fr) * LS + fq * 8, oacc[m]);
#pragma unroll
            for (int jj = 0; jj < 4; ++jj) { const int i = 16 * m + 4 * fq + jj; OUTS[i * 136 + 16 * w + fr] = (bf16_t)f2bf(oacc[m][jj]); } }
        __syncthreads();
#pragma unroll
        for (int q = 0; q < 2; ++q) { const int chunk = tid + q * 512, row = chunk >> 4, c8 = (chunk & 15) * 8;
            *(bf16x8*)(OUT + ACT(step, row) * ostride + c8) = *(const bf16x8*)(OUTS + row * 136 + c8); }
    }
#undef ACT
#undef PREFETCH
}
__device__ __forceinline__ void combine(const Params& P, int layer, int wid_s, int cb, int ncb) {
    unsigned char* ws = P.ws; bf16_t* Y = (bf16_t*)(ws + WS_Y); const bf16_t* OB = (const bf16_t*)(ws + WS_OB); const bf16_t* GG = (const bf16_t*)(ws + WS_GG);
    const int tid = tid_now(wid_s), lane = tid & 63, gw = (cb * 512 + tid) >> 6, nw = (ncb * 512) >> 6, c0 = lane * 8;
    float gn[8];
#pragma unroll
    for (int e = 0; e < 8; ++e) gn[e] = P.gla_norm[layer * 128 + (c0 & 127) + e];
    for (int row = gw; row < T; row += nw) {
        const bf16x8 a = *(const bf16x8*)(Y + (size_t)row * 1024 + 512 + c0), bq = *(const bf16x8*)(OB + (size_t)row * 512 + c0), gg = *(const bf16x8*)(GG + (size_t)row * 512 + c0);
        float v[8]; float ss = 0.f;
#pragma unroll
        for (int e = 0; e < 8; ++e) { v[e] = bf2f((unsigned short)a[e]) + bf2f((unsigned short)bq[e]); ss += v[e] * v[e]; }
        ss += shx(ss, lane, 1); ss += shx(ss, lane, 2); ss += shx(ss, lane, 4); ss += shx(ss, lane, 8);
        const float r = rsqrtf(ss * (1.f / 128.f) + EPS);
#pragma unroll
        for (int e = 0; e < 8; ++e) v[e] = v[e] * r * gn[e] * bf2f((unsigned short)gg[e]);
        u32x4 wv; wv.x = cvt_pk_bf16(v[0], v[1]); wv.y = cvt_pk_bf16(v[2], v[3]); wv.z = cvt_pk_bf16(v[4], v[5]); wv.w = cvt_pk_bf16(v[6], v[7]);
        *(u32x4*)(Y + (size_t)row * 1024 + 512 + c0) = wv;
    }
}
}

constexpr int LDS_BYTES = 163840;
static_assert(att::SHM_ATTN <= LDS_BYTES && gla::LDS_END <= LDS_BYTES && pg8::STAGE_BYTES <= LDS_BYTES, "LDS map");

template <class Epi> __device__ __forceinline__ void run_gemm(unsigned char* lds, const bf16_t* A, const bf16_t* Bt, int N, int K, const Epi& E, int wid_s, int Gov = 0, int cov = 0) {
    pg8::Gemm g; g.A = A; g.Bt = Bt; g.M = T; g.N = N; g.K = K;
    int G_ = Gov ? Gov : (int)gridDim.x, c_ = Gov ? cov : (int)blockIdx.x; asm volatile("" : "+s"(G_), "+s"(c_));
    pg8::StaticOrder S; S.init(T, N, G_, c_);
#ifndef NO_GEMM
    pg8::gemm_phase<Epi, pg8::StaticOrder, true, false>((PG8_LAS unsigned char*)lds, g, S, E, wid_s);
#endif
}

#define KP ((const volatile __attribute__((address_space(4))) Params*)__builtin_amdgcn_kernarg_segment_ptr())
__device__ __forceinline__ Params load_params() {
    Params L; L.x = KP->x; L.p = KP->p; L.pos = KP->pos; L.ln_mix = KP->ln_mix; L.w_in = KP->w_in; L.q_norm = KP->q_norm; L.w_uq = KP->w_uq; L.kv_norm = KP->kv_norm; L.w_ukv = KP->w_ukv;
    L.wgf = KP->wgf; L.bgf = KP->bgf; L.wgb = KP->wgb; L.bgb = KP->bgb; L.gla_norm = KP->gla_norm; L.w_out = KP->w_out; L.ple_norm = KP->ple_norm; L.w_pg = KP->w_pg; L.w_pp = KP->w_pp;
    L.final_norm = KP->final_norm; L.out = KP->out; L.ws = KP->ws; return L;
}

__device__ __forceinline__ void grid_bar(int idx, int wid_s) {
    __syncthreads();
    if (tid_now(wid_s) == 0) {
        unsigned* bar = (unsigned*)(KP->ws + WS_END);
        const unsigned gen = (unsigned)idx * gridDim.x;
        __builtin_amdgcn_fence(__ATOMIC_RELEASE, "agent"); asm volatile("s_waitcnt vmcnt(0)" ::: "memory");
        __hip_atomic_fetch_add(bar, 1u, __ATOMIC_RELAXED, __HIP_MEMORY_SCOPE_AGENT);
        while (__hip_atomic_load(bar, __ATOMIC_RELAXED, __HIP_MEMORY_SCOPE_AGENT) < gen) __builtin_amdgcn_s_sleep(40);
        __builtin_amdgcn_fence(__ATOMIC_ACQUIRE, "agent"); asm volatile("s_waitcnt vmcnt(0)" ::: "memory");
    }
    __syncthreads();
}
__global__ void __launch_bounds__(512, 2) hymba_fwd(Params Punused) {
    extern __shared__ __attribute__((aligned(16))) unsigned char lds[];
    cg::grid_group grid = cg::this_grid();
    const int wid_s = __builtin_amdgcn_readfirstlane(threadIdx.x >> 6);
    { const Params P = load_params(); prologue(P, wid_s, (float*)lds); }
    grid.sync();
    for (int l = 0; l < 2; ++l) {
        {
            unsigned char* ws = KP->ws; unsigned char* wb = ws + WS_W + l * W_LSTRIDE;
            Epi1 E; E.wsb = ws; run_gemm(lds, (const bf16_t*)(ws + WS_XBA), (const bf16_t*)(wb + WO_IN), DINP, 1024, E, wid_s);
        }
        grid_bar(l * 5 + 1, wid_s);
        {
            unsigned char* ws = KP->ws; unsigned char* wb = ws + WS_W + l * W_LSTRIDE;
            EpiQ EQ; EQ.wsb = ws; run_gemm(lds, (const bf16_t*)(ws + WS_CQ), (const bf16_t*)(wb + WO_UQ), 768, 384, EQ, wid_s);
            EpiKV EK; EK.wsb = ws; run_gemm(lds, (const bf16_t*)(ws + WS_CKV), (const bf16_t*)(wb + WO_UKV), 1024, 256, EK, wid_s);
        }
        grid_bar(l * 5 + 2, wid_s);
        {
            int G = gridDim.x, c = blockIdx.x; asm volatile("" : "+s"(G), "+s"(c));
#ifndef NO_GLA
            if (c < 64) {
                const Params P = load_params(); gla::stream(P, l, c, (char*)lds, wid_s);
                __syncthreads();
                if (tid_now(wid_s) == 0) { unsigned* gb = (unsigned*)(P.ws + WS_END + 3072) + l * 16;
                    __builtin_amdgcn_fence(__ATOMIC_RELEASE, "agent"); asm volatile("s_waitcnt vmcnt(0)" ::: "memory"); __hip_atomic_fetch_add(gb, 1u, __ATOMIC_RELAXED, __HIP_MEMORY_SCOPE_AGENT);
                    while (__hip_atomic_load(gb, __ATOMIC_RELAXED, __HIP_MEMORY_SCOPE_AGENT) < 64u) __builtin_amdgcn_s_sleep(2);
                    __builtin_amdgcn_fence(__ATOMIC_ACQUIRE, "agent"); asm volatile("s_waitcnt vmcnt(0)" ::: "memory"); }
                __syncthreads();
                gla::combine(P, l, wid_s, c, 64);
            }
#endif
            __syncthreads();
            if (c >= 64) {
            unsigned char* ws = KP->ws;
            bf16_t* Qb = (bf16_t*)(ws + WS_Q); bf16_t* Kb = (bf16_t*)(ws + WS_K); bf16_t* Vb = (bf16_t*)(ws + WS_V); bf16_t* GA = (bf16_t*)(ws + WS_GA); bf16_t* Y = (bf16_t*)(ws + WS_Y);
            unsigned* qctr = (unsigned*)(ws + WS_END + 256) + l * 8 * 16;
            volatile int* slot = (volatile int*)(lds + 90112);
            const int x0 = c & 7;
            for (int qi = 0; qi < 8; ++qi) { const int xq = (x0 + qi) & 7;
                for (;;) {
                    if (tid_now(wid_s) == 0) *slot = (int)__hip_atomic_fetch_add(qctr + 16 * xq, 1u, __ATOMIC_RELAXED, __HIP_MEMORY_SCOPE_AGENT);
                    __syncthreads();
                    const int u = __builtin_amdgcn_readfirstlane(*slot);
                    __syncthreads();
                    if (u >= 64) break;
                    const int bh = xq * 4 + (u >> 4), qb = u & 15, b = bh >> 2, h = bh & 3; const size_t r0 = (size_t)b * SEQ + qb * 256;
#ifndef NO_ATTN
                    att::attn_unit(Qb + r0 * 768 + h * 192, Kb + (size_t)b * SEQ * 768 + h * 192, Vb + (size_t)b * SEQ * 512 + h * 128, GA + r0 * 512 + h * 128, Y + r0 * 1024 + h * 128, SEQ, (char*)lds, wid_s);
#endif
                }
            }
                { unsigned* pctr = (unsigned*)(ws + WS_END + 3584) + l * 16; const float* psrc = KP->p + (size_t)l * T * 256; bf16_t* PBl = (bf16_t*)(ws + WS_PB) + (size_t)l * T * 256;
                  for (;;) {
                    if (tid_now(wid_s) == 0) *slot = (int)__hip_atomic_fetch_add(pctr, 1u, __ATOMIC_RELAXED, __HIP_MEMORY_SCOPE_AGENT);
                    __syncthreads();
                    const int ch = __builtin_amdgcn_readfirstlane(*slot);
                    __syncthreads();
                    if (ch >= 64) break;
                    const size_t base = (size_t)ch * (T * 256 / 64) + (size_t)tid_now(wid_s) * 8;
#pragma unroll 1
                    for (int it = 0; it < 32; it += 4) { f32x4 a[4], b[4];
#pragma unroll
                        for (int t = 0; t < 4; ++t) { const size_t o = base + (size_t)(it + t) * 4096; a[t] = *(const f32x4*)(psrc + o); b[t] = *(const f32x4*)(psrc + o + 4); }
#pragma unroll
                        for (int t = 0; t < 4; ++t) { const size_t o = base + (size_t)(it + t) * 4096; *(u32x4*)(PBl + o) = pack8(a[t], b[t]); } }
                  } }
                if (l == 0) {
                    unsigned* wctr = (unsigned*)(ws + WS_END + 3840);
                    for (;;) {
                        if (tid_now(wid_s) == 0) *slot = (int)__hip_atomic_fetch_add(wctr, 1u, __ATOMIC_RELAXED, __HIP_MEMORY_SCOPE_AGENT);
                        __syncthreads();
                        const int ch = __builtin_amdgcn_readfirstlane(*slot);
                        __syncthreads();
                        if (ch >= 64) break;
                        const Params P = load_params(); conv_layer_weights(P, 1, (float*)lds, tid_now(wid_s), ch, 64);
                    }
                }
            }
        }
        grid_bar(l * 5 + 3, wid_s);
        {
            unsigned char* ws = KP->ws; unsigned char* wb = ws + WS_W + l * W_LSTRIDE;
            { EpiPP EP; EP.PPd = (bf16_t*)KP->out; run_gemm(lds, (const bf16_t*)(ws + WS_PB) + (size_t)l * T * 256, (const bf16_t*)(wb + WO_PP), 1024, 256, EP, wid_s); }
            EpiOut EO; EO.HIN = l == 0 ? KP->x : nullptr; EO.wsb = ws; run_gemm(lds, (const bf16_t*)(ws + WS_Y), (const bf16_t*)(wb + WO_OUT), 1024, 1024, EO, wid_s);
        }
        grid_bar(l * 5 + 4, wid_s);
        {
            unsigned char* ws = KP->ws; unsigned char* wb = ws + WS_W + l * W_LSTRIDE;
            EpiPle EG; EG.PPd = (const bf16_t*)KP->out; EG.wsb = ws; run_gemm(lds, (const bf16_t*)(ws + WS_XBB), (const bf16_t*)(wb + WO_PG), 1024, 1024, EG, wid_s);
        }
        grid_bar(l * 5 + 5, wid_s);
    }
    {
        const Params P = load_params(); const float* SSA = (const float*)(P.ws + WS_SSA); const bf16_t* XA = (const bf16_t*)(P.ws + WS_XBA);
        const int tid = tid_now(wid_s), lane = tid & 63, gw = (blockIdx.x * 512 + tid) >> 6, nw = (gridDim.x * 512) >> 6;
        f32x4 ga[2], gb2[2];
#pragma unroll
        for (int it = 0; it < 2; ++it) { ga[it] = *(const f32x4*)(P.final_norm + it * 512 + lane * 8); gb2[it] = *(const f32x4*)(P.final_norm + it * 512 + lane * 8 + 4); }
        for (int row = gw; row < T; row += nw) { float s = SSA[(size_t)row * 16 + (lane & 15)]; u32x4 w[2];
#pragma unroll
            for (int it = 0; it < 2; ++it) w[it] = *(const u32x4*)(XA + (size_t)row * 1024 + it * 512 + lane * 8);
            s += shx(s, lane, 1); s += shx(s, lane, 2); s += shx(s, lane, 4); s += shx(s, lane, 8); const float r = rsqrtf(s * (1.f / 1024.f) + EPS);
#pragma unroll
            for (int it = 0; it < 2; ++it) { f32x4 a, b; unpack8(w[it], a, b); float* po = P.out + (size_t)row * 1024 + it * 512 + lane * 8;
                *(f32x4*)po = a * r * ga[it]; *(f32x4*)(po + 4) = b * r * gb2[it]; } }
    }
}

extern "C" void kernel_launch(void* const* d_in, const int* in_sizes, int n_in, void* d_out, int out_size, void* d_ws, size_t ws_size, hipStream_t stream) {
    static int grid_blocks = 0;
    if (n_in != 19 || ws_size < WS_END + 4096) { fprintf(stderr, "kernel_launch: unexpected inputs (n_in %d, ws %zu)\n", n_in, ws_size); return; }
    if (!grid_blocks) {
        if (hipFuncSetAttribute((const void*)hymba_fwd, hipFuncAttributeMaxDynamicSharedMemorySize, LDS_BYTES) != hipSuccess) { fprintf(stderr, "hipFuncSetAttribute failed\n"); return; }
        int dev = 0, cus = 0, per_cu = 0; hipGetDevice(&dev); hipDeviceGetAttribute(&cus, hipDeviceAttributeMultiprocessorCount, dev);
        if (hipOccupancyMaxActiveBlocksPerMultiprocessor(&per_cu, (const void*)hymba_fwd, 512, LDS_BYTES) != hipSuccess || per_cu < 1) { fprintf(stderr, "occupancy query failed\n"); return; }
        grid_blocks = cus;
    }
    Params P{};
    P.x = (const float*)d_in[0]; P.p = (const float*)d_in[1]; P.pos = (const int*)d_in[2]; P.ln_mix = (const float*)d_in[3]; P.w_in = (const float*)d_in[4]; P.q_norm = (const float*)d_in[5];
    P.w_uq = (const float*)d_in[6]; P.kv_norm = (const float*)d_in[7]; P.w_ukv = (const float*)d_in[8]; P.wgf = (const float*)d_in[9]; P.bgf = (const float*)d_in[10]; P.wgb = (const float*)d_in[11];
    P.bgb = (const float*)d_in[12]; P.gla_norm = (const float*)d_in[13]; P.w_out = (const float*)d_in[14]; P.ple_norm = (const float*)d_in[15]; P.w_pg = (const float*)d_in[16]; P.w_pp = (const float*)d_in[17];
    P.final_norm = (const float*)d_in[18]; P.out = (float*)d_out; P.ws = (unsigned char*)d_ws;
    if (hipMemsetAsync((char*)d_ws + WS_END, 0, 4096, stream) != hipSuccess) { fprintf(stderr, "memset failed\n"); return; }
    void* args[] = {&P};
    hipError_t e = hipLaunchCooperativeKernel((const void*)hymba_fwd, dim3(grid_blocks), dim3(512), args, LDS_BYTES, stream);
    if (e != hipSuccess) fprintf(stderr, "cooperative launch failed: %s (grid %d)\n", hipGetErrorString(e), grid_blocks);
}
```

```cpp
#include <hip/hip_runtime.h>
#include <hip/hip_cooperative_groups.h>
#include <cstdio>
#include <cstdint>
namespace cg = cooperative_groups;

__device__ __forceinline__ int tid_now(int wid_s) { int l; asm volatile("v_mbcnt_lo_u32_b32 %0, -1, 0\n\tv_mbcnt_hi_u32_b32 %0, -1, %0" : "=v"(l)); return (wid_s << 6) | l; }
__device__ __forceinline__ float shx(float v, int lane, int mask) { return __builtin_bit_cast(float, __builtin_amdgcn_ds_bpermute((lane ^ mask) << 2, __builtin_bit_cast(int, v))); }
namespace pg8 {
#define PG8_LAS __attribute__((address_space(3)))
typedef unsigned short bf16_t;
typedef short bf16x8 __attribute__((ext_vector_type(8)));
typedef float f32x4 __attribute__((ext_vector_type(4)));
typedef unsigned u32x4 __attribute__((ext_vector_type(4)));
constexpr int BM = 256, BK = 64, HALF = 128, HTB = HALF * BK * 2  , STAGE_BYTES = 8 * HTB, NXCD = 8, WGM = 8;

__host__ __device__ __forceinline__ int lds_byte(int r, int c) { const int st = (r >> 4) * 2 + (c >> 5), rr = r & 15, cc = c & 31, ob = rr * 64 + cc * 2; return st * 1024 + (ob ^ (((ob >> 9) & 1) << 5)); }
__host__ __device__ __forceinline__ void stage_rc(int b, int& R, int& C) { const int st = b / 1024, sb = b % 1024, swz = sb ^ (((sb >> 9) & 1) << 5); R = (st >> 1) * 16 + swz / 64; C = (st & 1) * 32 + (swz % 64) / 2; }
__host__ __device__ __forceinline__ int perm32(int rho) { const int n = rho >> 4, i = rho & 15; return 8 * (i >> 2) + 4 * n + (i & 3); }

struct Unit { int pm, pn; };
struct Gemm { const bf16_t* A; const bf16_t* Bt; int M, N, K; };

struct StaticOrder {
    int nM, nN, nwg, G, c;
    __host__ __device__ void init(int M, int N, int G_, int c_) { nM = M / BM; nN = N / BM; nwg = nM * nN; G = G_; c = c_; }
    __host__ __device__ bool next(int i, Unit& u) const {
        const long L = (long)i * G + c; if (L >= nwg) return false;
        int wgid = (int)L; { const int q = nwg / NXCD, r = nwg % NXCD, xcd = wgid % NXCD, off = wgid / NXCD; wgid = (xcd < r ? xcd * (q + 1) : r * (q + 1) + (xcd - r) * q) + off; }
        const int nig = WGM * nN, gid = wgid / nig, fm = gid * WGM, gsz = (nM - fm) < WGM ? (nM - fm) : WGM;
        u.pm = fm + ((wgid % nig) % gsz); u.pn = (wgid % nig) / gsz; return true;
    }
    __device__ __forceinline__ void a_ready(const Unit&) const {}
    __device__ __forceinline__ void done(const Unit&) const {}
};
__device__ __forceinline__ unsigned cvt_pk_bf16(float lo, float hi) { unsigned r; asm volatile("v_cvt_pk_bf16_f32 %0, %1, %2" : "=v"(r) : "v"(lo), "v"(hi)); return r; }
template <class Epi, class Sched, bool ALIGN_EPI = false, bool SP2 = false>
__device__ __forceinline__ void gemm_phase(PG8_LAS unsigned char* lds, const Gemm g, const Sched& S, const Epi& E, int wid_s) {
    int widl_ = wid_s; asm volatile("" : "+s"(widl_));
    const int tid = tid_now(widl_), wid = widl_, lane = tid & 63, wr = wid >> 2, wc = wid & 3, fr = lane & 15, fq = lane >> 4;
    const int K = g.K, nt = K / BK;
    unsigned voffA[2], voffB[2];
#pragma unroll
    for (int i = 0; i < 2; ++i) { int R, C; stage_rc(tid * 16 + i * 8192, R, C); const int Rb = Epi::PERM ? ((R & ~31) + perm32(R & 31)) : R;
        voffA[i] = (unsigned)(R * K + C) * 2u; voffB[i] = (unsigned)(Rb * K + C) * 2u; }
    const size_t kstep = (size_t)(BK * 2);
    const size_t hstep = (size_t)HALF * K * 2;
    const size_t tstep = 2 * hstep;
    const unsigned ldsw = (unsigned)wid * 1024u;
    const int aoff = lds_byte(wr * 64 + fr, fq * 8), boff = lds_byte(wc * 32 + fr, fq * 8);
#define PG8_SA(b, h) (((b) * 2 + (h)) * HTB)
#define PG8_SB(b, h) ((4 + (b) * 2 + (h)) * HTB)
#define PG8_STAGE(bufoff, gbase, voff) do { _Pragma("unroll") for (int _i = 0; _i < 2; ++_i) \
        __builtin_amdgcn_global_load_lds((const unsigned*)((const char*)(gbase) + (voff)[_i]), (PG8_LAS unsigned*)(lds + (bufoff) + ldsw + _i * 8192), 16, 0, 0); } while (0)
#define PG8_LDA(dst, b, h) do { _Pragma("unroll") for (int m = 0; m < 4; ++m) _Pragma("unroll") for (int k = 0; k < 2; ++k) dst[m][k] = *(const PG8_LAS bf16x8*)(lds + PG8_SA(b, h) + aoff + m * 2048 + k * 1024); } while (0)
#define PG8_LDB(dst, b, h) do { _Pragma("unroll") for (int n = 0; n < 2; ++n) _Pragma("unroll") for (int k = 0; k < 2; ++k) dst[n][k] = *(const PG8_LAS bf16x8*)(lds + PG8_SB(b, h) + boff + n * 2048 + k * 1024); } while (0)
#define PG8_MMA(ai, bj, At, Bt) do { __builtin_amdgcn_s_setprio(1); _Pragma("unroll") for (int m = 0; m < 4; ++m) _Pragma("unroll") for (int n = 0; n < 2; ++n) _Pragma("unroll") for (int k = 0; k < 2; ++k) \
        acc[ai][bj][m][n] = __builtin_amdgcn_mfma_f32_16x16x32_bf16(Bt[n][k], At[m][k], acc[ai][bj][m][n], 0, 0, 0); __builtin_amdgcn_s_setprio(0); } while (0)
#define PG8_WAIT_V(n) asm volatile("s_waitcnt vmcnt(" #n ")" ::: "memory")
#define PG8_WAIT_L(n) asm volatile("s_waitcnt lgkmcnt(" #n ")" ::: "memory")
#define PG8_BAR __builtin_amdgcn_s_barrier()
#define PG8_SCHED __builtin_amdgcn_sched_barrier(0)
    Unit cur, nxt; int ui = 0;
    if (!S.next(0, cur)) return;
    f32x4 acc[2][2][4][2];
#pragma unroll
    for (int a = 0; a < 2; ++a)
#pragma unroll
        for (int b = 0; b < 2; ++b)
#pragma unroll
            for (int m = 0; m < 4; ++m)
#pragma unroll
                for (int n = 0; n < 2; ++n) acc[a][b][m][n] = (f32x4){0.f, 0.f, 0.f, 0.f};
    bf16x8 At[4][2], B0[2][2], B1[2][2];
    const char* cA = (const char*)g.A + (size_t)cur.pm * tstep; const char* cB = (const char*)g.Bt + (size_t)cur.pn * tstep;
    S.a_ready(cur);
    if constexpr (SP2) {
        PG8_STAGE(PG8_SB(0, 0), cB, voffB); PG8_STAGE(PG8_SB(0, 1), cB + hstep, voffB); PG8_STAGE(PG8_SA(0, 0), cA, voffA); PG8_STAGE(PG8_SA(0, 1), cA + hstep, voffA);
        if (wr == 1) PG8_BAR;
        PG8_WAIT_V(2); PG8_BAR;
        PG8_STAGE(PG8_SB(1, 0), cB + kstep, voffB); PG8_STAGE(PG8_SA(1, 0), cA + kstep, voffA); PG8_STAGE(PG8_SB(1, 1), cB + hstep + kstep, voffB);
        PG8_WAIT_V(6); PG8_BAR;
    } else {
        PG8_STAGE(PG8_SB(0, 0), cB, voffB); PG8_STAGE(PG8_SA(0, 0), cA, voffA); PG8_STAGE(PG8_SB(0, 1), cB + hstep, voffB); PG8_STAGE(PG8_SA(0, 1), cA + hstep, voffA);
        if (wr == 1) PG8_BAR;
        PG8_WAIT_V(4); PG8_BAR;
        PG8_STAGE(PG8_SB(1, 0), cB + kstep, voffB); PG8_STAGE(PG8_SA(1, 0), cA + kstep, voffA); PG8_STAGE(PG8_SB(1, 1), cB + hstep + kstep, voffB);
        PG8_WAIT_V(6); PG8_BAR;
    }
    for (;;) {
        const bool has_next = S.next(ui + 1, nxt);
        const char* nA = has_next ? (const char*)g.A + (size_t)nxt.pm * tstep : cA; const char* nB = has_next ? (const char*)g.Bt + (size_t)nxt.pn * tstep : cB;
        for (int t = 0; t < nt; t += 2) {
            const bool last = (t == nt - 2);
            const char* a1 = cA + (size_t)(t + 1) * kstep;
            const char* a2 = last ? nA : cA + (size_t)(t + 2) * kstep; const char* b2 = last ? nB : cB + (size_t)(t + 2) * kstep;
            const char* a3 = a2 + kstep; const char* b3 = b2 + kstep;
            if (last && has_next) S.a_ready(nxt);
            if constexpr (SP2) {
            PG8_LDB(B0, 0, 0); PG8_LDB(B1, 0, 1); PG8_SCHED; PG8_LDA(At, 0, 0); PG8_STAGE(PG8_SA(1, 1), a1 + hstep, voffA);
            PG8_WAIT_V(8); PG8_WAIT_L(0); PG8_BAR; PG8_MMA(0, 0, At, B0); PG8_MMA(0, 1, At, B1); PG8_BAR; PG8_SCHED;
            PG8_LDA(At, 0, 1); PG8_STAGE(PG8_SB(0, 0), b2, voffB); PG8_STAGE(PG8_SB(0, 1), b2 + hstep, voffB); PG8_STAGE(PG8_SA(0, 0), a2, voffA);
            PG8_WAIT_V(8); PG8_WAIT_L(0); PG8_BAR; PG8_MMA(1, 0, At, B0); PG8_MMA(1, 1, At, B1); PG8_BAR; PG8_SCHED;
            PG8_LDB(B0, 1, 0); PG8_LDB(B1, 1, 1); PG8_SCHED; PG8_LDA(At, 1, 0); PG8_STAGE(PG8_SA(0, 1), a2 + hstep, voffA);
            PG8_WAIT_V(8); PG8_WAIT_L(0); PG8_BAR; PG8_MMA(0, 0, At, B0); PG8_MMA(0, 1, At, B1); PG8_BAR; PG8_SCHED;
            PG8_LDA(At, 1, 1); PG8_STAGE(PG8_SB(1, 0), b3, voffB); PG8_STAGE(PG8_SB(1, 1), b3 + hstep, voffB); PG8_STAGE(PG8_SA(1, 0), a3, voffA);
            PG8_WAIT_V(8); PG8_WAIT_L(0); PG8_BAR; PG8_MMA(1, 0, At, B0); PG8_MMA(1, 1, At, B1); PG8_BAR; PG8_SCHED;
            } else {
            PG8_LDB(B0, 0, 0); PG8_SCHED; PG8_LDA(At, 0, 0); PG8_STAGE(PG8_SA(1, 1), a1 + hstep, voffA);
            PG8_WAIT_L(8); PG8_BAR; PG8_WAIT_L(0); PG8_MMA(0, 0, At, B0); PG8_BAR; PG8_SCHED;
            PG8_LDB(B1, 0, 1); PG8_STAGE(PG8_SB(0, 0), b2, voffB);
            PG8_BAR; PG8_WAIT_L(0); PG8_MMA(0, 1, At, B1); PG8_BAR;
            PG8_LDA(At, 0, 1); PG8_STAGE(PG8_SA(0, 0), a2, voffA);
            PG8_BAR; PG8_WAIT_L(0); PG8_MMA(1, 0, At, B0); PG8_BAR; PG8_SCHED;
            PG8_STAGE(PG8_SB(0, 1), b2 + hstep, voffB);
            PG8_WAIT_V(6); PG8_BAR; PG8_MMA(1, 1, At, B1); PG8_BAR;
            PG8_LDB(B0, 1, 0); PG8_SCHED; PG8_LDA(At, 1, 0); PG8_STAGE(PG8_SA(0, 1), a2 + hstep, voffA);
            PG8_WAIT_L(8); PG8_BAR; PG8_WAIT_L(0); PG8_MMA(0, 0, At, B0); PG8_BAR; PG8_SCHED;
            PG8_LDB(B1, 1, 1); PG8_STAGE(PG8_SB(1, 0), b3, voffB);
            PG8_BAR; PG8_WAIT_L(0); PG8_MMA(0, 1, At, B1); PG8_BAR;
            PG8_LDA(At, 1, 1); PG8_STAGE(PG8_SA(1, 0), a3, voffA);
            PG8_BAR; PG8_WAIT_L(0); PG8_MMA(1, 0, At, B0); PG8_BAR; PG8_SCHED;
            PG8_STAGE(PG8_SB(1, 1), b3 + hstep, voffB);
            PG8_WAIT_V(6); PG8_BAR; PG8_MMA(1, 1, At, B1); PG8_BAR;
            }
        }
        if constexpr (ALIGN_EPI) { if (wr == 0) PG8_BAR; }
        if constexpr (!Epi::AFTER_DRAIN) { E(acc, cur, wr, wc, fr, fq); S.done(cur); }
        if (!has_next) break;
#pragma unroll
        for (int a = 0; a < 2; ++a)
#pragma unroll
            for (int b = 0; b < 2; ++b)
#pragma unroll
                for (int m = 0; m < 4; ++m)
#pragma unroll
                    for (int n = 0; n < 2; ++n) acc[a][b][m][n] = (f32x4){0.f, 0.f, 0.f, 0.f};
        cur = nxt; cA = nA; cB = nB; ++ui;
        if constexpr (ALIGN_EPI) { if (wr == 1) PG8_BAR; }
    }
    PG8_WAIT_V(0);
    if constexpr (!ALIGN_EPI) { if (wr == 0) PG8_BAR; }
    PG8_BAR;
    if constexpr (Epi::AFTER_DRAIN) { E.fused(acc, cur, wr, wc, fr, fq, lds, wid, lane); S.done(cur); }
#undef PG8_SA
#undef PG8_SB
#undef PG8_STAGE
#undef PG8_LDA
#undef PG8_LDB
#undef PG8_MMA
#undef PG8_WAIT_V
#undef PG8_WAIT_L
#undef PG8_BAR
#undef PG8_SCHED
}
}

using pg8::bf16_t; using pg8::bf16x8; using pg8::f32x4; using pg8::u32x4; using pg8::cvt_pk_bf16;
typedef float f32x16 __attribute__((ext_vector_type(16)));
typedef short s16x4 __attribute__((ext_vector_type(4)));
typedef float f32x2 __attribute__((ext_vector_type(2)));
#define LAS3 __attribute__((address_space(3)))

constexpr int T = 32768, SEQ = 4096, DM = 1024, DIN = 2784, DINP = 2816;
constexpr float EPS = 1e-6f;
constexpr size_t MiB = 1u << 20;
constexpr size_t WS_W = 0, W_LSTRIDE = 12 * MiB, WO_IN = 0, WO_UQ = 6 * MiB, WO_UKV = 7 * MiB, WO_PP = 7 * MiB + 512 * 1024, WO_OUT = 8 * MiB, WO_PG = 10 * MiB;
constexpr size_t WS_ROPE = 24 * MiB, WS_SSA = 32 * MiB, WS_SSB = 34 * MiB, WS_SSC = 36 * MiB, WS_XBA = 40 * MiB, WS_PB = 104 * MiB;
constexpr size_t WS_CQ = 136 * MiB, WS_CKV = 160 * MiB, WS_OB = 136 * MiB  ;
constexpr size_t WS_GQ = 176 * MiB, WS_GK = 192 * MiB, WS_LR = 208 * MiB, WS_GV = 210 * MiB, WS_GA = 242 * MiB, WS_GG = 274 * MiB;
constexpr size_t WS_Q = 306 * MiB, WS_K = 354 * MiB, WS_V = 402 * MiB, WS_XBB = 306 * MiB  , WS_PP = 370 * MiB  ;
constexpr size_t WS_Y = 434 * MiB, WS_END = 498 * MiB;

struct Params {
    const float *x, *p; const int* pos;
    const float *ln_mix, *w_in, *q_norm, *w_uq, *kv_norm, *w_ukv, *wgf, *bgf, *wgb, *bgb, *gla_norm, *w_out, *ple_norm, *w_pg, *w_pp, *final_norm;
    float* out; unsigned char* ws;
};

__device__ __forceinline__ unsigned f2bf(float f) { unsigned u = __builtin_bit_cast(unsigned, f); return (u + 0x7fffu + ((u >> 16) & 1u)) >> 16; }
__device__ __forceinline__ float bf2f(unsigned short h) { return __builtin_bit_cast(float, (unsigned)h << 16); }
__device__ __forceinline__ u32x4 pack8(f32x4 a, f32x4 b) { u32x4 w; w.x = cvt_pk_bf16(a[0], a[1]); w.y = cvt_pk_bf16(a[2], a[3]); w.z = cvt_pk_bf16(b[0], b[1]); w.w = cvt_pk_bf16(b[2], b[3]); return w; }
__device__ __forceinline__ float dot4(f32x4 a) { return (a[0] * a[0] + a[1] * a[1]) + (a[2] * a[2] + a[3] * a[3]); }
__device__ __forceinline__ float sigmoidf_(float v) { return __builtin_amdgcn_rcpf(1.f + __expf(-v)); }
__device__ __forceinline__ f32x4 silu4(f32x4 v) { f32x4 o; o[0] = v[0] * sigmoidf_(v[0]); o[1] = v[1] * sigmoidf_(v[1]); o[2] = v[2] * sigmoidf_(v[2]); o[3] = v[3] * sigmoidf_(v[3]); return o; }

__device__ __forceinline__ int wmap(int mode, int n, float& sc) {
    sc = 1.f;
    if (mode == 0) return n;
    if (mode == 1) {
        if (n < 640) return n;
        if (n < 768) { const int w = n - 640; if (w < 64) { const int i = w >> 1, s = w & 1; return 640 + (s ? 32 + i : i); } if (w < 80) return 2240 + (w - 64); if (w < 96) return 2256 + (w - 80); return -1; }
        if (n < 1280) return 704 + (n - 768);
        if (n < 1536) { sc = 0.125f; return 1216 + (n - 1280); }
        if (n < 1792) return 1472 + (n - 1536);
        if (n < 2304) return 1728 + (n - 1792);
        return 2272 + (n - 2304);
    }
    if (mode == 2) {
        const int h = n / 192, j = n % 192; if (j < 128) return n; const int w = j - 128, i = w >> 1, s = w & 1; return h * 192 + 128 + (s ? 32 + i : i);
    }
    if (n < 512) { const int h = n >> 7, j = n & 127; return h * 256 + j; }
    { const int m = n - 512, h = m >> 7, j = m & 127; return h * 256 + 128 + j; }
}
__device__ __forceinline__ void conv_w(const float* __restrict__ src, int K, int Nsrc, bf16_t* __restrict__ dst, int Ndst, const float* __restrict__ gain, int mode, int gtid, int gsz) {
    const int total = Ndst * (K / 8);
    for (int idx = gtid; idx < total; idx += gsz) {
        const int n = idx % Ndst, k0 = (idx / Ndst) * 8; float sc; const int s = wmap(mode, n, sc);
        float v[8];
#pragma unroll
        for (int j = 0; j < 8; ++j) v[j] = (s >= 0) ? src[(size_t)(k0 + j) * Nsrc + s] * (gain ? gain[k0 + j] : 1.f) * sc : 0.f;
        u32x4 w; w.x = cvt_pk_bf16(v[0], v[1]); w.y = cvt_pk_bf16(v[2], v[3]); w.z = cvt_pk_bf16(v[4], v[5]); w.w = cvt_pk_bf16(v[6], v[7]);
        *(u32x4*)(dst + (size_t)n * K + k0) = w;
    }
}
__device__ __forceinline__ void conv_w_tiled(const float* __restrict__ src, int K, int Nsrc, bf16_t* __restrict__ dst, int Ndst, const float* __restrict__ gain, int mode, float* tile, int tid, int first, int stride) {
    const int ntn = Ndst >> 6, nt = ntn * (K >> 6);
    const int nn = tid & 63, kq = tid >> 6, nn2 = tid >> 3, kseg = tid & 7;
    for (int t = first; t < nt; t += stride) {
        const int n0 = (t % ntn) * 64, k0 = (t / ntn) * 64;
        float sc; const int sidx = wmap(mode, n0 + nn, sc);
        float v[8];
#pragma unroll
        for (int i = 0; i < 8; ++i) v[i] = (sidx >= 0) ? src[(size_t)(k0 + kq + 8 * i) * Nsrc + sidx] * sc : 0.f;
#pragma unroll
        for (int i = 0; i < 8; ++i) tile[(kq + 8 * i) * 65 + nn] = v[i];
        __syncthreads();
        float o[8];
#pragma unroll
        for (int j = 0; j < 8; ++j) o[j] = tile[(kseg * 8 + j) * 65 + nn2] * (gain ? gain[k0 + kseg * 8 + j] : 1.f);
        u32x4 w; w.x = cvt_pk_bf16(o[0], o[1]); w.y = cvt_pk_bf16(o[2], o[3]); w.z = cvt_pk_bf16(o[4], o[5]); w.w = cvt_pk_bf16(o[6], o[7]);
        *(u32x4*)(dst + (size_t)(n0 + nn2) * K + k0 + kseg * 8) = w;
        __syncthreads();
    }
}
__device__ __forceinline__ void conv_layer_weights(const Params& P, int l, float* tile, int tid, int first, int stride) {
    unsigned char* wb = P.ws + WS_W + l * W_LSTRIDE;
    conv_w_tiled(P.w_in + (size_t)l * DM * DIN, 1024, DIN, (bf16_t*)(wb + WO_IN), DINP, P.ln_mix + l * 1024, 1, tile, tid, first, stride);
    conv_w_tiled(P.w_uq + (size_t)l * 384 * 768, 384, 768, (bf16_t*)(wb + WO_UQ), 768, P.q_norm + l * 384, 2, tile, tid, first, stride);
    conv_w_tiled(P.w_ukv + (size_t)l * 256 * 1024, 256, 1024, (bf16_t*)(wb + WO_UKV), 1024, P.kv_norm + l * 256, 3, tile, tid, first, stride);
    conv_w_tiled(P.w_pp + (size_t)l * 256 * 1024, 256, 1024, (bf16_t*)(wb + WO_PP), 1024, nullptr, 0, tile, tid, first, stride);
    conv_w_tiled(P.w_out + (size_t)l * 1024 * 1024, 1024, 1024, (bf16_t*)(wb + WO_OUT), 1024, nullptr, 0, tile, tid, first, stride);
    conv_w_tiled(P.w_pg + (size_t)l * 1024 * 1024, 1024, 1024, (bf16_t*)(wb + WO_PG), 1024, P.ple_norm + l * 1024, 0, tile, tid, first, stride);
}
__device__ __forceinline__ void prologue(const Params& P, int wid_s, float* tile) {
    const int tid = tid_now(wid_s); const int gtid = blockIdx.x * 512 + tid, gsz = gridDim.x * 512;
    unsigned char* ws = P.ws;
    conv_layer_weights(P, 0, tile, tid, blockIdx.x, gridDim.x);
    { f32x2* R = (f32x2*)(ws + WS_ROPE);
      for (int i = gtid; i < T * 32; i += gsz) { const int row = i >> 5, k = i & 31; const float inv = powf(10000.f, -(float)k / 32.f); const float ang = (float)P.pos[row] * inv;
        double rev = (double)ang * 0.15915494309189535; rev -= floor(rev); const float rf = (float)rev;
        f32x2 cs; cs.x = __builtin_amdgcn_cosf(rf); cs.y = __builtin_amdgcn_sinf(rf); R[i] = cs; } }
    { bf16_t* XB = (bf16_t*)(ws + WS_XBA); float* SS = (float*)(ws + WS_SSA); const int lane = tid & 63, gw = gtid >> 6, nw = gsz >> 6;
      for (int row = gw; row < T; row += nw) { float s = 0.f;
#pragma unroll
        for (int it = 0; it < 4; ++it) { const int col = it * 256 + lane * 4; const f32x4 v = *(const f32x4*)(P.x + (size_t)row * 1024 + col); s += dot4(v);
          f32x2 o; ((unsigned*)&o)[0] = cvt_pk_bf16(v[0], v[1]); ((unsigned*)&o)[1] = cvt_pk_bf16(v[2], v[3]); *(f32x2*)(XB + (size_t)row * 1024 + col) = o; }
#pragma unroll
        for (int o = 32; o >= 1; o >>= 1) s += shx(s, lane, o);
        if (lane < 16) SS[(size_t)row * 16 + lane] = (lane == 0) ? s : 0.f; } }
}

#define GAS1 __attribute__((address_space(1)))
__device__ __forceinline__ void gst16(void* p, u32x4 v) { *(GAS1 u32x4*)p = v; }
__device__ __forceinline__ void gst16f(void* p, f32x4 v) { *(GAS1 f32x4*)p = v; }
__device__ __forceinline__ void gst4f(void* p, float v) { *(GAS1 float*)p = v; }
__device__ __forceinline__ f32x4 gld16f(const void* p) { return *(const GAS1 f32x4*)p; }
__device__ __forceinline__ u32x4 gld16(const void* p) { return *(const GAS1 u32x4*)p; }
__device__ __forceinline__ void unpack8(u32x4 w, f32x4& a, f32x4& b) {
    a[0] = __builtin_bit_cast(float, w.x << 16); a[1] = __builtin_bit_cast(float, w.x & 0xffff0000u); a[2] = __builtin_bit_cast(float, w.y << 16); a[3] = __builtin_bit_cast(float, w.y & 0xffff0000u);
    b[0] = __builtin_bit_cast(float, w.z << 16); b[1] = __builtin_bit_cast(float, w.z & 0xffff0000u); b[2] = __builtin_bit_cast(float, w.w << 16); b[3] = __builtin_bit_cast(float, w.w & 0xffff0000u);
}
__device__ __forceinline__ void row_rstd(float (&rs)[2][4], const float* __restrict__ Pp, int stride, int off, int np, float invdim, int row0, int fq, int ln_) {
    f32x4 v[2][4];
#pragma unroll
    for (int ai = 0; ai < 2; ++ai)
#pragma unroll
        for (int m = 0; m < 4; ++m) v[ai][m] = (4 * fq < np) ? gld16f(Pp + (size_t)(row0 + ai * 128 + m * 16) * stride + off + 4 * fq) : (f32x4){0.f, 0.f, 0.f, 0.f};
#pragma unroll
    for (int ai = 0; ai < 2; ++ai)
#pragma unroll
        for (int m = 0; m < 4; ++m) { float s = (v[ai][m][0] + v[ai][m][1]) + (v[ai][m][2] + v[ai][m][3]);
            s += shx(s, ln_, 16); s += shx(s, ln_, 32); rs[ai][m] = rsqrtf(s * invdim + EPS); }
}
__device__ __forceinline__ void rope8(f32x4& v0, f32x4& v1, const f32x2* __restrict__ rp) {
    const f32x4 c01 = gld16f(rp), c23 = gld16f(rp + 2);
    f32x4 o0, o1;
    o0[0] = v0[0] * c01[0] - v0[1] * c01[1]; o0[1] = v0[0] * c01[1] + v0[1] * c01[0];
    o0[2] = v0[2] * c01[2] - v0[3] * c01[3]; o0[3] = v0[2] * c01[3] + v0[3] * c01[2];
    o1[0] = v1[0] * c23[0] - v1[1] * c23[1]; o1[1] = v1[0] * c23[1] + v1[1] * c23[0];
    o1[2] = v1[2] * c23[2] - v1[3] * c23[3]; o1[3] = v1[2] * c23[3] + v1[3] * c23[2];
    v0 = o0; v1 = o1;
}
struct Epi1 {
    static constexpr bool PERM = true, AFTER_DRAIN = false;
    unsigned char* wsb;
    __device__ __forceinline__ void operator()(const f32x4 (&acc)[2][2][4][2], const pg8::Unit& u, int wr, int wc, int fr, int fq) const {
        const int ln_ = tid_now(0) & 63; fr = ln_ & 15; fq = ln_ >> 4;
        unsigned char* ws = wsb; asm volatile("" : "+s"(ws));
        const float* SS = (const float*)(ws + WS_SSA); const f32x2* rope = (const f32x2*)(ws + WS_ROPE); float* SSC = (float*)(ws + WS_SSC);
        bf16_t* CQ = (bf16_t*)(ws + WS_CQ); bf16_t* CKV = (bf16_t*)(ws + WS_CKV); bf16_t* K = (bf16_t*)(ws + WS_K); bf16_t* LR = (bf16_t*)(ws + WS_LR); bf16_t* GA = (bf16_t*)(ws + WS_GA);
        bf16_t* GQ = (bf16_t*)(ws + WS_GQ); bf16_t* GK = (bf16_t*)(ws + WS_GK); bf16_t* GV = (bf16_t*)(ws + WS_GV); bf16_t* GG = (bf16_t*)(ws + WS_GG);
        const int row0 = u.pm * 256 + wr * 64 + fr; float rs[2][4]; row_rstd(rs, SS, 16, 0, 16, 1.f / 1024.f, row0, fq, ln_);
        const int hc = wc * 32 + fq * 8;
#pragma unroll
        for (int bj = 0; bj < 2; ++bj) { const int hf = u.pn * 2 + bj;
#pragma unroll
            for (int ai = 0; ai < 2; ++ai)
#pragma unroll
                for (int m = 0; m < 4; ++m) { const size_t row = (size_t)(row0 + ai * 128 + m * 16); const float r = rs[ai][m];
                    f32x4 v0 = acc[ai][bj][m][0] * r, v1 = acc[ai][bj][m][1] * r;
                    if (hf < 5) { float ss = dot4(v0) + dot4(v1); ss += shx(ss, ln_, 16); ss += shx(ss, ln_, 32); const u32x4 w = pack8(v0, v1);
                        if (hf < 3) { gst16(CQ + row * 384 + hf * 128 + hc, w); if (fq == 0) gst4f(SSC + (row * 32 + hf * 4 + wc), ss); }
                        else { gst16(CKV + row * 256 + (hf - 3) * 128 + hc, w); if (fq == 0) gst4f(SSC + (row * 32 + 12 + (hf - 3) * 4 + wc), ss); } }
                    else if (hf == 5) {
                        if (wc < 2) { rope8(v0, v1, rope + row * 32 + (hc >> 1)); const u32x4 w = pack8(v0, v1);
#pragma unroll
                            for (int h = 0; h < 4; ++h) gst16(K + row * 768 + h * 192 + 128 + hc, w); }
                        else if (wc == 2) { gst16(LR + row * 32 + (hc - 64), pack8(v0, v1)); } }
                    else if (hf < 10) { gst16(GA + row * 512 + (hf - 6) * 128 + hc, pack8(silu4(v0), silu4(v1))); }
                    else if (hf < 12) { gst16(GQ + row * 256 + (hf - 10) * 128 + hc, pack8(v0, v1)); }
                    else if (hf < 14) { gst16(GK + row * 256 + (hf - 12) * 128 + hc, pack8(v0, v1)); }
                    else if (hf < 18) { gst16(GV + row * 512 + (hf - 14) * 128 + hc, pack8(v0, v1)); }
                    else { gst16(GG + row * 512 + (hf - 18) * 128 + hc, pack8(silu4(v0), silu4(v1))); }
                } }
    }
};
struct EpiQ {
    static constexpr bool PERM = true, AFTER_DRAIN = false;
    unsigned char* wsb;
    __device__ __forceinline__ void operator()(const f32x4 (&acc)[2][2][4][2], const pg8::Unit& u, int wr, int wc, int fr, int fq) const {
        const int ln_ = tid_now(0) & 63; fr = ln_ & 15; fq = ln_ >> 4;
        unsigned char* ws = wsb; asm volatile("" : "+s"(ws));
        const float* SSC = (const float*)(ws + WS_SSC); const f32x2* rope = (const f32x2*)(ws + WS_ROPE); bf16_t* Q = (bf16_t*)(ws + WS_Q);
        const int row0 = u.pm * 256 + wr * 64 + fr; float rs[2][4]; row_rstd(rs, SSC, 32, 0, 12, 1.f / 384.f, row0, fq, ln_);
        const int hc = wc * 32 + fq * 8;
#pragma unroll
        for (int bj = 0; bj < 2; ++bj) { const int hf = u.pn * 2 + bj, hm = hf % 3; const bool rw = (hm == 1 && wc < 2) || (hm == 2 && wc >= 2);
            const int col = hf * 128 + hc, i0 = ((col % 192) - 128) >> 1;
#pragma unroll
            for (int ai = 0; ai < 2; ++ai)
#pragma unroll
                for (int m = 0; m < 4; ++m) { const size_t row = (size_t)(row0 + ai * 128 + m * 16); const float r = rs[ai][m];
                    f32x4 v0 = acc[ai][bj][m][0] * r, v1 = acc[ai][bj][m][1] * r;
                    if (rw) rope8(v0, v1, rope + row * 32 + i0);
                    gst16(Q + row * 768 + col, pack8(v0, v1)); } }
    }
};
struct EpiKV {
    static constexpr bool PERM = true, AFTER_DRAIN = false;
    unsigned char* wsb;
    __device__ __forceinline__ void operator()(const f32x4 (&acc)[2][2][4][2], const pg8::Unit& u, int wr, int wc, int fr, int fq) const {
        const int ln_ = tid_now(0) & 63; fr = ln_ & 15; fq = ln_ >> 4;
        unsigned char* ws = wsb; asm volatile("" : "+s"(ws));
        const float* SSC = (const float*)(ws + WS_SSC); bf16_t* K = (bf16_t*)(ws + WS_K); bf16_t* V = (bf16_t*)(ws + WS_V);
        const int row0 = u.pm * 256 + wr * 64 + fr; float rs[2][4]; row_rstd(rs, SSC, 32, 12, 8, 1.f / 256.f, row0, fq, ln_);
        const int hc = wc * 32 + fq * 8;
#pragma unroll
        for (int bj = 0; bj < 2; ++bj) { const int hf = u.pn * 2 + bj;
#pragma unroll
            for (int ai = 0; ai < 2; ++ai)
#pragma unroll
                for (int m = 0; m < 4; ++m) { const size_t row = (size_t)(row0 + ai * 128 + m * 16); const float r = rs[ai][m];
                    const u32x4 w = pack8(acc[ai][bj][m][0] * r, acc[ai][bj][m][1] * r);
                    if (hf < 4) gst16(K + row * 768 + hf * 192 + hc, w); else gst16(V + row * 512 + (hf - 4) * 128 + hc, w); } }
    }
};
struct EpiOut {
    static constexpr bool PERM = true, AFTER_DRAIN = false;
    const float* HIN; unsigned char* wsb;
    template <bool F32IN> __device__ __forceinline__ void body(const f32x4 (&acc)[2][2][4][2], const pg8::Unit& u, int wr, int wc, int fr, int fq, int ln_, unsigned char* ws) const {
        bf16_t* XB = (bf16_t*)(ws + WS_XBB); const bf16_t* XA = (const bf16_t*)(ws + WS_XBA); float* SSo = (float*)(ws + WS_SSB);
        const int row0 = u.pm * 256 + wr * 64 + fr, hc = wc * 32 + fq * 8;
#pragma unroll
        for (int ai = 0; ai < 2; ++ai)
#pragma unroll
            for (int mp = 0; mp < 2; ++mp) {
                f32x4 ha[2][2], hb[2][2];
#pragma unroll
                for (int mm = 0; mm < 2; ++mm)
#pragma unroll
                    for (int bj = 0; bj < 2; ++bj) { const size_t o = (size_t)(row0 + ai * 128 + (mp * 2 + mm) * 16) * 1024 + u.pn * 256 + bj * 128 + hc;
                        if constexpr (F32IN) { ha[mm][bj] = gld16f(HIN + o); hb[mm][bj] = gld16f(HIN + o + 4); } else { ha[mm][bj] = __builtin_bit_cast(f32x4, gld16(XA + o)); } }
#pragma unroll
                for (int mm = 0; mm < 2; ++mm) { const int m = mp * 2 + mm; const size_t row = (size_t)(row0 + ai * 128 + m * 16); float ss = 0.f;
#pragma unroll
                    for (int bj = 0; bj < 2; ++bj) { const size_t o = row * 1024 + u.pn * 256 + bj * 128 + hc; f32x4 a, b;
                        if constexpr (F32IN) { a = ha[mm][bj]; b = hb[mm][bj]; } else unpack8(__builtin_bit_cast(u32x4, ha[mm][bj]), a, b);
                        const f32x4 v0 = acc[ai][bj][m][0] + a, v1 = acc[ai][bj][m][1] + b;
                        gst16(XB + o, pack8(v0, v1)); ss += dot4(v0) + dot4(v1); }
                    ss += shx(ss, ln_, 16); ss += shx(ss, ln_, 32); gst4f(SSo + (row * 16 + u.pn * 4 + wc), ss); }
            }
    }
    __device__ __forceinline__ void operator()(const f32x4 (&acc)[2][2][4][2], const pg8::Unit& u, int wr, int wc, int fr, int fq) const {
        const int ln_ = tid_now(0) & 63; fr = ln_ & 15; fq = ln_ >> 4;
        unsigned char* ws = wsb; asm volatile("" : "+s"(ws));
        if (HIN != nullptr) body<true>(acc, u, wr, wc, fr, fq, ln_, ws); else body<false>(acc, u, wr, wc, fr, fq, ln_, ws);
    }
};
struct EpiPP {
    static constexpr bool PERM = true, AFTER_DRAIN = false;
    bf16_t* PPd;
    __device__ __forceinline__ void operator()(const f32x4 (&acc)[2][2][4][2], const pg8::Unit& u, int wr, int wc, int fr, int fq) const {
        const int ln_ = tid_now(0) & 63; fr = ln_ & 15; fq = ln_ >> 4;
        bf16_t* PP = PPd; asm volatile("" : "+s"(PP));
        const int row0 = u.pm * 256 + wr * 64 + fr, hc = wc * 32 + fq * 8;
#pragma unroll
        for (int ai = 0; ai < 2; ++ai)
#pragma unroll
            for (int m = 0; m < 4; ++m)
#pragma unroll
                for (int bj = 0; bj < 2; ++bj) gst16(PP + (size_t)(row0 + ai * 128 + m * 16) * 1024 + u.pn * 256 + bj * 128 + hc, pack8(acc[ai][bj][m][0], acc[ai][bj][m][1]));
    }
};
struct EpiPle {
    static constexpr bool PERM = true, AFTER_DRAIN = false;
    const bf16_t* PPd; unsigned char* wsb;
    __device__ __forceinline__ void operator()(const f32x4 (&acc)[2][2][4][2], const pg8::Unit& u, int wr, int wc, int fr, int fq) const {
        const int ln_ = tid_now(0) & 63; fr = ln_ & 15; fq = ln_ >> 4;
        unsigned char* ws = wsb; asm volatile("" : "+s"(ws));
        const float* SSin = (const float*)(ws + WS_SSB); const bf16_t* PP = PPd; asm volatile("" : "+s"(PP)); const bf16_t* XH = (const bf16_t*)(ws + WS_XBB); bf16_t* XB = (bf16_t*)(ws + WS_XBA); float* SSo = (float*)(ws + WS_SSA);
        const int row0 = u.pm * 256 + wr * 64 + fr, hc = wc * 32 + fq * 8; float rs[2][4]; row_rstd(rs, SSin, 16, 0, 16, 1.f / 1024.f, row0, fq, ln_);
#pragma unroll
        for (int ai = 0; ai < 2; ++ai)
#pragma unroll
            for (int mp = 0; mp < 2; ++mp) {
                u32x4 pw[2][2], hw[2][2];
#pragma unroll
                for (int mm = 0; mm < 2; ++mm)
#pragma unroll
                    for (int bj = 0; bj < 2; ++bj) { const size_t o = (size_t)(row0 + ai * 128 + (mp * 2 + mm) * 16) * 1024 + u.pn * 256 + bj * 128 + hc; pw[mm][bj] = gld16(PP + o); hw[mm][bj] = gld16(XH + o); }
#pragma unroll
                for (int mm = 0; mm < 2; ++mm) { const int m = mp * 2 + mm; const size_t row = (size_t)(row0 + ai * 128 + m * 16); const float r = rs[ai][m]; float ss = 0.f;
#pragma unroll
                    for (int bj = 0; bj < 2; ++bj) { const size_t o = row * 1024 + u.pn * 256 + bj * 128 + hc;
                        f32x4 p0, p1, h0, h1; unpack8(pw[mm][bj], p0, p1); unpack8(hw[mm][bj], h0, h1);
                        const f32x4 a0 = acc[ai][bj][m][0] * r, a1 = acc[ai][bj][m][1] * r; f32x4 v0, v1;
#pragma unroll
                        for (int e = 0; e < 4; ++e) { v0[e] = h0[e] + sigmoidf_(a0[e]) * p0[e]; v1[e] = h1[e] + sigmoidf_(a1[e]) * p1[e]; }
                        gst16(XB + o, pack8(v0, v1));
                        ss += dot4(v0) + dot4(v1); }
                    ss += shx(ss, ln_, 16); ss += shx(ss, ln_, 32); gst4f(SSo + (row * 16 + u.pn * 4 + wc), ss); }
            }
    }
};
namespace att {
constexpr int NW = 8, QBLK = 32, KVBLK = 64, LDQ = 768, LDK = 768, LDV = 512;
constexpr float SCALE = 0.07216878364870322f;
constexpr float THR = 8.f;
constexpr int SHM_V = 64 * 128 * 2, SHM_K = 64 * 400, SHM_ATTN = 2 * SHM_V + 2 * SHM_K + NW * 64 * 4;
#define KSWZ(row, colB) ((row) * 400 + (colB))
#define SBAR() __builtin_amdgcn_sched_barrier(0)
__device__ __forceinline__ int crow(int r, int hi) { return (r & 3) + 8 * (r >> 2) + 4 * hi; }
__device__ __forceinline__ unsigned cvtpk(float lo, float hi) { unsigned r; asm volatile("v_cvt_pk_bf16_f32 %0, %1, %2" : "=v"(r) : "v"(lo), "v"(hi)); return r; }
__device__ __forceinline__ void partialSM(f32x16& p0, f32x16& p1, float& m_reg, float& mn, float& alpha) {
  constexpr float C = SCALE * 1.4426950408889634f;
  float pmax = p0[0];
#pragma unroll
  for (int r = 1; r < 16; ++r) pmax = fmaxf(pmax, p0[r]);
#pragma unroll
  for (int r = 0; r < 16; ++r) pmax = fmaxf(pmax, p1[r]);
  { auto rr = __builtin_amdgcn_permlane32_swap(__float_as_uint(pmax), __float_as_uint(pmax), false, false);
    pmax = fmaxf(__uint_as_float(rr[0]), __uint_as_float(rr[1])); }
  if (__builtin_expect(__all(pmax - m_reg <= THR / SCALE), 1)) { mn = m_reg; alpha = 1.f; }
  else { mn = fmaxf(m_reg, pmax); alpha = __builtin_amdgcn_exp2f((m_reg - mn) * C); m_reg = mn; }
  float mnC = -mn * C;
#pragma unroll
  for (int r = 0; r < 16; ++r) p0[r] = fmaf(p0[r], C, mnC);
#pragma unroll
  for (int r = 0; r < 16; ++r) p1[r] = fmaf(p1[r], C, mnC);
#pragma unroll
  for (int r = 0; r < 16; ++r) p0[r] = __builtin_amdgcn_exp2f(p0[r]);
}
__device__ __forceinline__ void finishSM(f32x16& p0, f32x16& p1, float alpha, float& l_reg, bf16x8& pa0, bf16x8& pa1, bf16x8& pa2, bf16x8& pa3) {
#pragma unroll
  for (int r = 0; r < 16; ++r) p1[r] = __builtin_amdgcn_exp2f(p1[r]);
  float ps = 0;
#pragma unroll
  for (int r = 0; r < 16; ++r) ps += p0[r];
#pragma unroll
  for (int r = 0; r < 16; ++r) ps += p1[r];
  { auto rr = __builtin_amdgcn_permlane32_swap(__float_as_uint(ps), __float_as_uint(ps), false, false);
    ps = __uint_as_float(rr[0]) + __uint_as_float(rr[1]); }
  l_reg = l_reg * alpha + ps;
#define PK4(P, BASE, OUT) do { unsigned a0 = cvtpk(P[BASE + 0], P[BASE + 1]), a1 = cvtpk(P[BASE + 2], P[BASE + 3]);   \
    unsigned b0 = cvtpk(P[BASE + 4], P[BASE + 5]), b1 = cvtpk(P[BASE + 6], P[BASE + 7]);                              \
    auto r0 = __builtin_amdgcn_permlane32_swap(a0, b0, false, false); auto r1 = __builtin_amdgcn_permlane32_swap(a1, b1, false, false); \
    u32x4 w = {r0[0], r1[0], r0[1], r1[1]}; OUT = *reinterpret_cast<bf16x8*>(&w); } while (0)
  PK4(p0, 0, pa0); PK4(p0, 8, pa1); PK4(p1, 0, pa2); PK4(p1, 8, pa3);
#undef PK4
}
__device__ __forceinline__ void qkt(f32x16& p0, f32x16& p1, const char* Ks, const bf16x8* qr, int r32, int hi) {
  p0 = f32x16{}; p1 = f32x16{};
  const char* kb_ = Ks + r32 * 400 + hi * 16;
#pragma unroll
  for (int d0 = 0; d0 < 12; ++d0) {
    bf16x8 b0 = *reinterpret_cast<const bf16x8*>(kb_ + d0 * 32);
    bf16x8 b1 = *reinterpret_cast<const bf16x8*>(kb_ + 32 * 400 + d0 * 32);
    p0 = __builtin_amdgcn_mfma_f32_32x32x16_bf16(b0, qr[d0], p0, 0, 0, 0);
    p1 = __builtin_amdgcn_mfma_f32_32x32x16_bf16(b1, qr[d0], p1, 0, 0, 0); }
}
__device__ __forceinline__ int v_st(int k, int c) { const int kk = (k & ~0xC) | ((k & 4) << 1) | ((k & 8) >> 1); return ((kk >> 3) * 4 + (c >> 5)) * 512 + ((kk & 7) * 32 + (c & 31)) * 2; }
__device__ __forceinline__ int v_rd_base(int lane) { return ((lane & 3) << 3) | (((lane >> 2) & 3) << 6) | (((lane >> 4) & 1) << 5) | (((lane >> 5) & 1) << 8); }
constexpr int v_rd_off(int d0, int ks, int half) { return d0 * 512 + ks * 4096 + half * 2048; }
template <int OFF> __device__ __forceinline__ s16x4 tr_read(int vb) {
  s16x4 r; asm volatile("ds_read_b64_tr_b16 %0, %1 offset:%2" : "=&v"(r) : "v"(vb), "i"(OFF) : "memory"); return r;
}
template <int D0> __device__ __forceinline__ void pv_one(f32x16& od, int vb, bf16x8 pa0, bf16x8 pa1, bf16x8 pa2, bf16x8 pa3) {
  const s16x4 l0 = tr_read<v_rd_off(D0, 0, 0)>(vb), h0 = tr_read<v_rd_off(D0, 0, 1)>(vb), l1 = tr_read<v_rd_off(D0, 1, 0)>(vb), h1 = tr_read<v_rd_off(D0, 1, 1)>(vb);
  const s16x4 l2 = tr_read<v_rd_off(D0, 2, 0)>(vb), h2 = tr_read<v_rd_off(D0, 2, 1)>(vb), l3 = tr_read<v_rd_off(D0, 3, 0)>(vb), h3 = tr_read<v_rd_off(D0, 3, 1)>(vb);
  asm volatile("s_waitcnt lgkmcnt(0)" ::: "memory"); SBAR();
#define PK(L, H) (bf16x8){L[0], L[1], L[2], L[3], H[0], H[1], H[2], H[3]}
  od = __builtin_amdgcn_mfma_f32_32x32x16_bf16(pa0, PK(l0, h0), od, 0, 0, 0);
  od = __builtin_amdgcn_mfma_f32_32x32x16_bf16(pa1, PK(l1, h1), od, 0, 0, 0);
  od = __builtin_amdgcn_mfma_f32_32x32x16_bf16(pa2, PK(l2, h2), od, 0, 0, 0);
  od = __builtin_amdgcn_mfma_f32_32x32x16_bf16(pa3, PK(l3, h3), od, 0, 0, 0);
#undef PK
}
__device__ __forceinline__ void pv_d0(f32x16* o, int vb, bf16x8 pa0, bf16x8 pa1, bf16x8 pa2, bf16x8 pa3) {
  pv_one<0>(o[0], vb, pa0, pa1, pa2, pa3); pv_one<1>(o[1], vb, pa0, pa1, pa2, pa3); pv_one<2>(o[2], vb, pa0, pa1, pa2, pa3); pv_one<3>(o[3], vb, pa0, pa1, pa2, pa3);
}
__device__ __forceinline__ void attn_unit(const bf16_t* __restrict__ Qb, const bf16_t* __restrict__ Kh, const bf16_t* __restrict__ Vh,
                                          const bf16_t* __restrict__ Gb, bf16_t* __restrict__ Ob, int seq, char* lds, int wid_s) {
  const int tid = tid_now(wid_s), wid = tid >> 6, lane = tid & 63, r32 = lane & 31, hi = lane >> 5;
  char* V_lds = lds; char* K_lds = lds + 2 * SHM_V;
  float* ws = (float*)(lds + 2 * SHM_V + 2 * SHM_K) + wid * 64; float* li_l = ws; float* al_l = ws + 32;
  float m_reg = -1e30f, l_reg = 0; f32x16 o[4] = {}; bf16x8 qr[12];
  const bf16_t* Qw = Qb + (size_t)(wid * QBLK + r32) * LDQ + hi * 8;
#pragma unroll
  for (int d0 = 0; d0 < 12; ++d0) qr[d0] = *(const bf16x8*)(Qw + d0 * 16);
  const int sr = tid >> 4, sc = (tid & 15) * 8, vst0 = v_st(sr, sc), vst1 = v_st(32 + sr, sc);
  const int kc0 = tid, kc1 = tid + 512, kc2 = tid + 1024;
  const int kr0 = kc0 / 24, kr1 = kc1 / 24, kr2 = kc2 / 24, kq0 = (kc0 % 24) * 8, kq1 = (kc1 % 24) * 8, kq2 = (kc2 % 24) * 8;
  const int kst0 = KSWZ(kr0, kq0 * 2), kst1 = KSWZ(kr1, kq1 * 2), kst2 = KSWZ(kr2, kq2 * 2);
  const int kg0 = kr0 * LDK + kq0, kg1 = kr1 * LDK + kq1, kg2 = kr2 * LDK + kq2;
  const int vb0 = (int)(uintptr_t)V_lds + v_rd_base(lane);
  bf16x8 vs0, vs1, ks0, ks1, ks2;
#define SLOAD(k0) do { vs0 = *(const bf16x8*)(Vh + (size_t)((k0) + sr) * LDV + sc); vs1 = *(const bf16x8*)(Vh + (size_t)((k0) + 32 + sr) * LDV + sc); \
    const bf16_t* kp_ = Kh + (size_t)(k0) * LDK; ks0 = *(const bf16x8*)(kp_ + kg0); ks1 = *(const bf16x8*)(kp_ + kg1); ks2 = *(const bf16x8*)(kp_ + kg2); } while (0)
#define SWRITE(b) do { *(bf16x8*)(V_lds + (b) * SHM_V + vst0) = vs0; *(bf16x8*)(V_lds + (b) * SHM_V + vst1) = vs1; \
    *(bf16x8*)(K_lds + (b) * SHM_K + kst0) = ks0; *(bf16x8*)(K_lds + (b) * SHM_K + kst1) = ks1; *(bf16x8*)(K_lds + (b) * SHM_K + kst2) = ks2; } while (0)
#define SWAIT() asm volatile("s_waitcnt vmcnt(0)" ::: "memory")
#define RESC(a) do { if (__any((a) < 1.f)) { if (hi == 0) al_l[r32] = (a); asm volatile("s_waitcnt lgkmcnt(0)" ::: "memory"); \
    _Pragma("unroll") for (int d = 0; d < 4; ++d) _Pragma("unroll") for (int r = 0; r < 16; ++r) o[d][r] *= al_l[crow(r, hi)]; } } while (0)
  f32x16 pA0, pA1, pB0, pB1; float mnA, mnB, alA, alB; bf16x8 pa0, pa1, pa2, pa3; const int NT = seq / KVBLK;
  SLOAD(0); SWAIT(); SWRITE(0); __syncthreads();
  qkt(pA0, pA1, K_lds, qr, r32, hi); partialSM(pA0, pA1, m_reg, mnA, alA);
  SLOAD(KVBLK); SWAIT(); SWRITE(1); __syncthreads();
  for (int j = 1; j + 1 < NT; j += 2) {
    SBAR(); qkt(pB0, pB1, K_lds + SHM_K, qr, r32, hi);
    finishSM(pA0, pA1, alA, l_reg, pa0, pa1, pa2, pa3); SBAR();
    SLOAD((j + 1) * KVBLK); SBAR();
    pv_d0(o, vb0, pa0, pa1, pa2, pa3); partialSM(pB0, pB1, m_reg, mnB, alB);
    __syncthreads(); SWAIT(); SWRITE(0);
    RESC(alB); __syncthreads();
    SBAR(); qkt(pA0, pA1, K_lds, qr, r32, hi);
    finishSM(pB0, pB1, alB, l_reg, pa0, pa1, pa2, pa3); SBAR();
    SLOAD((j + 2) * KVBLK); SBAR();
    pv_d0(o, vb0 + SHM_V, pa0, pa1, pa2, pa3); partialSM(pA0, pA1, m_reg, mnA, alA);
    __syncthreads(); SWAIT(); SWRITE(1);
    RESC(alA); __syncthreads();
  }
  SBAR(); qkt(pB0, pB1, K_lds + SHM_K, qr, r32, hi);
  finishSM(pA0, pA1, alA, l_reg, pa0, pa1, pa2, pa3); SBAR();
  pv_d0(o, vb0, pa0, pa1, pa2, pa3); partialSM(pB0, pB1, m_reg, mnB, alB);
  __syncthreads(); RESC(alB);
  finishSM(pB0, pB1, alB, l_reg, pa0, pa1, pa2, pa3); SBAR();
  pv_d0(o, vb0 + SHM_V, pa0, pa1, pa2, pa3);
  if (hi == 0) li_l[r32] = l_reg; asm volatile("s_waitcnt lgkmcnt(0)" ::: "memory");
  float rli[16];
#pragma unroll
  for (int r = 0; r < 16; ++r) rli[r] = __builtin_amdgcn_rcpf(li_l[crow(r, hi)]);
#pragma unroll
  for (int r = 0; r < 16; ++r) { const int orow = wid * QBLK + crow(r, hi);
#pragma unroll
    for (int d0 = 0; d0 < 4; ++d0) { const float g = bf2f(Gb[(size_t)orow * 512 + d0 * 32 + r32]); Ob[(size_t)orow * 1024 + d0 * 32 + r32] = (bf16_t)f2bf(o[d0][r] * rli[r] * g); } }
  __syncthreads();
#undef SLOAD
#undef SWRITE
#undef SWAIT
#undef RESC
}
}

namespace gla {
constexpr int LS = 72;
constexpr int O_QS = 0, O_KS = 8192, O_LR = 16384, O_TOT = 18432, O_DEC = 20480, O_QIN = 20736, O_KIN = O_QIN + 9216, O_QINTER = O_KIN + 9216, O_KST = O_QINTER + 9216,
              O_AM = O_KST + 9216, O_ST = O_AM + 9216, O_VT = O_ST + 18432, O_OUTS = O_VT + 18432, LDS_END = O_OUTS + 64 * 136 * 2;
__device__ __forceinline__ f32x4 mma16(const bf16_t* Ap, const bf16_t* Bp, f32x4 acc) {
    acc = __builtin_amdgcn_mfma_f32_16x16x32_bf16(*(const bf16x8*)Ap, *(const bf16x8*)Bp, acc, 0, 0, 0);
    acc = __builtin_amdgcn_mfma_f32_16x16x32_bf16(*(const bf16x8*)(Ap + 32), *(const bf16x8*)(Bp + 32), acc, 0, 0, 0);
    return acc;
}
__device__ __forceinline__ void stream(const Params& P, int layer, int sid, char* lds, int wid_s) {
    const int b = sid >> 3, h = (sid >> 1) & 3, dir = sid & 1;
    const int tid = tid_now(wid_s), lane = tid & 63, w = tid >> 6, d = lane, g = w, fr = lane & 15, fq = lane >> 4;
    unsigned char* ws = P.ws;
    const bf16_t* GQ = (const bf16_t*)(ws + WS_GQ) + h * 64; const bf16_t* GK = (const bf16_t*)(ws + WS_GK) + h * 64; const bf16_t* GV = (const bf16_t*)(ws + WS_GV) + h * 128;
    const bf16_t* LR = (const bf16_t*)(ws + WS_LR) + dir * 16;
    bf16_t* OUT = dir ? (bf16_t*)(ws + WS_OB) + h * 128 : (bf16_t*)(ws + WS_Y) + 512 + h * 128; const int ostride = dir ? 512 : 1024;
    float wreg[16];
    { const float* wg = (dir ? P.wgb : P.wgf) + layer * 16 * 256 + h * 64 + d;
#pragma unroll
      for (int r = 0; r < 16; ++r) wreg[r] = wg[r * 256]; }
    const float bias = (dir ? P.bgb : P.bgf)[layer * 256 + h * 64 + d];
    bf16_t* Qs = (bf16_t*)(lds + O_QS); bf16_t* Ks = (bf16_t*)(lds + O_KS); bf16_t* LRs = (bf16_t*)(lds + O_LR); float* TOT = (float*)(lds + O_TOT); float* DEC = (float*)(lds + O_DEC);
    bf16_t* QIN = (bf16_t*)(lds + O_QIN); bf16_t* KIN = (bf16_t*)(lds + O_KIN); bf16_t* QINTER = (bf16_t*)(lds + O_QINTER); bf16_t* KST = (bf16_t*)(lds + O_KST);
    bf16_t* AM = (bf16_t*)(lds + O_AM); bf16_t* ST = (bf16_t*)(lds + O_ST); bf16_t* VT = (bf16_t*)(lds + O_VT); bf16_t* OUTS = (bf16_t*)(lds + O_OUTS);
    f32x4 st[4];
#pragma unroll
    for (int m = 0; m < 4; ++m) st[m] = (f32x4){0.f, 0.f, 0.f, 0.f};
    const int qtok = tid >> 3, qc8 = tid & 7, vtok = tid & 63, vc8 = tid >> 6, ltok = tid >> 1, lhalf = tid & 1;
    const size_t tb = (size_t)b * SEQ;
#define ACT(step, tokp) (tb + (dir ? (63 - (step)) * 64 + (63 - (tokp)) : (step) * 64 + (tokp)))
    bf16x8 rq, rk, rv0, rv1, rl;
#define PREFETCH(step) do { const size_t tq_ = ACT(step, qtok), tv_ = ACT(step, vtok); \
        rq = *(const bf16x8*)(GQ + tq_ * 256 + qc8 * 8); rk = *(const bf16x8*)(GK + tq_ * 256 + qc8 * 8); \
        rv0 = *(const bf16x8*)(GV + tv_ * 512 + vc8 * 8); rv1 = *(const bf16x8*)(GV + tv_ * 512 + 64 + vc8 * 8); \
        if (tid < 128) rl = *(const bf16x8*)(LR + ACT(step, ltok) * 32 + lhalf * 8); } while (0)
    PREFETCH(0);
    for (int step = 0; step < 64; ++step) {
        *(bf16x8*)(Qs + qtok * 64 + qc8 * 8) = rq; *(bf16x8*)(Ks + qtok * 64 + qc8 * 8) = rk;
        if (tid < 128) *(bf16x8*)(LRs + ltok * 16 + lhalf * 8) = rl;
#pragma unroll
        for (int e = 0; e < 8; ++e) { VT[(vc8 * 8 + e) * LS + vtok] = (bf16_t)rv0[e]; VT[(64 + vc8 * 8 + e) * LS + vtok] = (bf16_t)rv1[e]; }
        __syncthreads();
        if (step + 1 < 64) PREFETCH(step + 1);
        float bb[8];
#pragma unroll
        for (int j = 0; j < 8; ++j) { const bf16x8 l0 = *(const bf16x8*)(LRs + (8 * g + j) * 16), l1 = *(const bf16x8*)(LRs + (8 * g + j) * 16 + 8); float z = bias;
#pragma unroll
            for (int r = 0; r < 8; ++r) { z = fmaf(bf2f((unsigned short)l0[r]), wreg[r], z); z = fmaf(bf2f((unsigned short)l1[r]), wreg[8 + r], z); }
            const float ls = fminf(z, 0.f) - __logf(1.f + __expf(-fabsf(z))); bb[j] = ls * (1.f / 16.f); }
#pragma unroll
        for (int j = 1; j < 8; ++j) bb[j] += bb[j - 1];
        TOT[g * 64 + d] = bb[7];
        __syncthreads();
        float pre = 0.f, ref = 0.f, blast = 0.f;
#pragma unroll
        for (int k = 0; k < 8; ++k) { const float t = TOT[k * 64 + d]; if (k < g) pre += t; if (k < 4) ref += t; blast += t; }
        { float kst[8];
#pragma unroll
          for (int j = 0; j < 8; ++j) { const float bj = pre + bb[j]; const int tok = 8 * g + j; const float q = bf2f(Qs[tok * 64 + d]), k = bf2f(Ks[tok * 64 + d]);
              QIN[tok * LS + d] = (bf16_t)f2bf(q * __expf(bj - ref)); KIN[tok * LS + d] = (bf16_t)f2bf(k * __expf(ref - bj)); QINTER[tok * LS + d] = (bf16_t)f2bf(q * __expf(bj));
              kst[j] = k * __expf(blast - bj); }
          u32x4 kw; kw.x = cvt_pk_bf16(kst[0], kst[1]); kw.y = cvt_pk_bf16(kst[2], kst[3]); kw.z = cvt_pk_bf16(kst[4], kst[5]); kw.w = cvt_pk_bf16(kst[6], kst[7]);
          *(u32x4*)(KST + d * LS + 8 * g) = kw; }
        if (g == 0) DEC[d] = __expf(blast);
#pragma unroll
        for (int m = 0; m < 4; ++m) { f32x2 sw; ((unsigned*)&sw)[0] = cvt_pk_bf16(st[m][0], st[m][1]); ((unsigned*)&sw)[1] = cvt_pk_bf16(st[m][2], st[m][3]);
            *(f32x2*)(ST + (16 * w + fr) * LS + 16 * m + 4 * fq) = sw; }
        __syncthreads();
#pragma unroll
        for (int e = 0; e < 2; ++e) { const int tile = 2 * w + e, mi = tile >> 2, nj = tile & 3;
            f32x4 a = mma16(QIN + (16 * mi + fr) * LS + fq * 8, KIN + (16 * nj + fr) * LS + fq * 8, (f32x4){0.f, 0.f, 0.f, 0.f});
#pragma unroll
            for (int jj = 0; jj < 4; ++jj) { const int i = 16 * mi + 4 * fq + jj, j = 16 * nj + fr; AM[i * LS + j] = (bf16_t)f2bf(j <= i ? a[jj] : 0.f); } }
        f32x4 oacc[4];
#pragma unroll
        for (int m = 0; m < 4; ++m) oacc[m] = mma16(QINTER + (16 * m + fr) * LS + fq * 8, ST + (16 * w + fr) * LS + fq * 8, (f32x4){0.f, 0.f, 0.f, 0.f});
#pragma unroll
        for (int m = 0; m < 4; ++m) { const f32x4 dc = *(const f32x4*)(DEC + 16 * m + 4 * fq); st[m] = mma16(KST + (16 * m + fr) * LS + fq * 8, VT + (16 * w + fr) * LS + fq * 8, st[m] * dc); }
        __syncthreads();
#pragma unroll
        for (int m = 0; m < 4; ++m) { oacc[m] = mma16(AM + (16 * m + fr) * LS + fq * 8, VT + (16 * w + fr) * LS + fq * 8, oacc[m]);
#pragma unroll
            for (int jj = 0; jj < 4; ++jj) { const int i = 16 * m + 4 * fq + jj; OUTS[i * 136 + 16 * w + fr] = (bf16_t)f2bf(oacc[m][jj]); } }
        __syncthreads();
#pragma unroll
        for (int q = 0; q < 2; ++q) { const int chunk = tid + q * 512, row = chunk >> 4, c8 = (chunk & 15) * 8;
            *(bf16x8*)(OUT + ACT(step, row) * ostride + c8) = *(const bf16x8*)(OUTS + row * 136 + c8); }
    }
#undef ACT
#undef PREFETCH
}
__device__ __forceinline__ void combine(const Params& P, int layer, int wid_s, int cb, int ncb) {
    unsigned char* ws = P.ws; bf16_t* Y = (bf16_t*)(ws + WS_Y); const bf16_t* OB = (const bf16_t*)(ws + WS_OB); const bf16_t* GG = (const bf16_t*)(ws + WS_GG);
    const int tid = tid_now(wid_s), lane = tid & 63, gw = (cb * 512 + tid) >> 6, nw = (ncb * 512) >> 6, c0 = lane * 8;
    float gn[8];
#pragma unroll
    for (int e = 0; e < 8; ++e) gn[e] = P.gla_norm[layer * 128 + (c0 & 127) + e];
    for (int row = gw; row < T; row += nw) {
        const bf16x8 a = *(const bf16x8*)(Y + (size_t)row * 1024 + 512 + c0), bq = *(const bf16x8*)(OB + (size_t)row * 512 + c0), gg = *(const bf16x8*)(GG + (size_t)row * 512 + c0);
        float v[8]; float ss = 0.f;
#pragma unroll
        for (int e = 0; e < 8; ++e) { v[e] = bf2f((unsigned short)a[e]) + bf2f((unsigned short)bq[e]); ss += v[e] * v[e]; }
        ss += shx(ss, lane, 1); ss += shx(ss, lane, 2); ss += shx(ss, lane, 4); ss += shx(ss, lane, 8);
        const float r = rsqrtf(ss * (1.f / 128.f) + EPS);
#pragma unroll
        for (int e = 0; e < 8; ++e) v[e] = v[e] * r * gn[e] * bf2f((unsigned short)gg[e]);
        u32x4 wv; wv.x = cvt_pk_bf16(v[0], v[1]); wv.y = cvt_pk_bf16(v[2], v[3]); wv.z = cvt_pk_bf16(v[4], v[5]); wv.w = cvt_pk_bf16(v[6], v[7]);
        *(u32x4*)(Y + (size_t)row * 1024 + 512 + c0) = wv;
    }
}
}

constexpr int LDS_BYTES = 131072;
static_assert(att::SHM_ATTN <= LDS_BYTES && gla::LDS_END <= LDS_BYTES && pg8::STAGE_BYTES <= LDS_BYTES, "LDS map");

template <class Epi> __device__ __forceinline__ void run_gemm(unsigned char* lds, const bf16_t* A, const bf16_t* Bt, int N, int K, const Epi& E, int wid_s, int Gov = 0, int cov = 0) {
    pg8::Gemm g; g.A = A; g.Bt = Bt; g.M = T; g.N = N; g.K = K;
    int G_ = Gov ? Gov : (int)gridDim.x, c_ = Gov ? cov : (int)blockIdx.x; asm volatile("" : "+s"(G_), "+s"(c_));
    pg8::StaticOrder S; S.init(T, N, G_, c_);
#ifndef NO_GEMM
    pg8::gemm_phase<Epi, pg8::StaticOrder, true, false>((PG8_LAS unsigned char*)lds, g, S, E, wid_s);
#endif
}

#define KP ((const volatile __attribute__((address_space(4))) Params*)__builtin_amdgcn_kernarg_segment_ptr())
__device__ __forceinline__ Params load_params() {
    Params L; L.x = KP->x; L.p = KP->p; L.pos = KP->pos; L.ln_mix = KP->ln_mix; L.w_in = KP->w_in; L.q_norm = KP->q_norm; L.w_uq = KP->w_uq; L.kv_norm = KP->kv_norm; L.w_ukv = KP->w_ukv;
    L.wgf = KP->wgf; L.bgf = KP->bgf; L.wgb = KP->wgb; L.bgb = KP->bgb; L.gla_norm = KP->gla_norm; L.w_out = KP->w_out; L.ple_norm = KP->ple_norm; L.w_pg = KP->w_pg; L.w_pp = KP->w_pp;
    L.final_norm = KP->final_norm; L.out = KP->out; L.ws = KP->ws; return L;
}

__device__ __forceinline__ void grid_bar(int idx, int wid_s) {
    __syncthreads();
    if (tid_now(wid_s) == 0) {
        unsigned* bar = (unsigned*)(KP->ws + WS_END);
        const unsigned gen = (unsigned)idx * gridDim.x;
        __builtin_amdgcn_fence(__ATOMIC_RELEASE, "agent"); asm volatile("s_waitcnt vmcnt(0)" ::: "memory");
        __hip_atomic_fetch_add(bar, 1u, __ATOMIC_RELAXED, __HIP_MEMORY_SCOPE_AGENT);
        while (__hip_atomic_load(bar, __ATOMIC_RELAXED, __HIP_MEMORY_SCOPE_AGENT) < gen) __builtin_amdgcn_s_sleep(40);
        __builtin_amdgcn_fence(__ATOMIC_ACQUIRE, "agent"); asm volatile("s_waitcnt vmcnt(0)" ::: "memory");
    }
    __syncthreads();
}
__global__ void __launch_bounds__(512, 2) hymba_fwd(Params Punused) {
    extern __shared__ __attribute__((aligned(16))) unsigned char lds[];
    cg::grid_group grid = cg::this_grid();
    const int wid_s = __builtin_amdgcn_readfirstlane(threadIdx.x >> 6);
    { const Params P = load_params(); prologue(P, wid_s, (float*)lds); }
    grid.sync();
    for (int l = 0; l < 2; ++l) {
        {
            unsigned char* ws = KP->ws; unsigned char* wb = ws + WS_W + l * W_LSTRIDE;
            Epi1 E; E.wsb = ws; run_gemm(lds, (const bf16_t*)(ws + WS_XBA), (const bf16_t*)(wb + WO_IN), DINP, 1024, E, wid_s);
        }
        grid_bar(l * 5 + 1, wid_s);
        {
            unsigned char* ws = KP->ws; unsigned char* wb = ws + WS_W + l * W_LSTRIDE;
            EpiQ EQ; EQ.wsb = ws; run_gemm(lds, (const bf16_t*)(ws + WS_CQ), (const bf16_t*)(wb + WO_UQ), 768, 384, EQ, wid_s);
            EpiKV EK; EK.wsb = ws; run_gemm(lds, (const bf16_t*)(ws + WS_CKV), (const bf16_t*)(wb + WO_UKV), 1024, 256, EK, wid_s);
        }
        grid_bar(l * 5 + 2, wid_s);
        {
            int G = gridDim.x, c = blockIdx.x; asm volatile("" : "+s"(G), "+s"(c));
#ifndef NO_GLA
            if (c < 64) {
                const Params P = load_params(); gla::stream(P, l, c, (char*)lds, wid_s);
                __syncthreads();
                if (tid_now(wid_s) == 0) { unsigned* gb = (unsigned*)(P.ws + WS_END + 3072) + l * 16;
                    __builtin_amdgcn_fence(__ATOMIC_RELEASE, "agent"); asm volatile("s_waitcnt vmcnt(0)" ::: "memory"); __hip_atomic_fetch_add(gb, 1u, __ATOMIC_RELAXED, __HIP_MEMORY_SCOPE_AGENT);
                    while (__hip_atomic_load(gb, __ATOMIC_RELAXED, __HIP_MEMORY_SCOPE_AGENT) < 64u) __builtin_amdgcn_s_sleep(24);
                    __builtin_amdgcn_fence(__ATOMIC_ACQUIRE, "agent"); asm volatile("s_waitcnt vmcnt(0)" ::: "memory"); }
                __syncthreads();
                gla::combine(P, l, wid_s, c, 64);
            }
#endif
            __syncthreads();
            if (c >= 64) {
            unsigned char* ws = KP->ws;
            bf16_t* Qb = (bf16_t*)(ws + WS_Q); bf16_t* Kb = (bf16_t*)(ws + WS_K); bf16_t* Vb = (bf16_t*)(ws + WS_V); bf16_t* GA = (bf16_t*)(ws + WS_GA); bf16_t* Y = (bf16_t*)(ws + WS_Y);
            unsigned* qctr = (unsigned*)(ws + WS_END + 256) + l * 8 * 16;
            volatile int* slot = (volatile int*)(lds + 90112);
            const int x0 = c & 7;
            for (int qi = 0; qi < 8; ++qi) { const int xq = (x0 + qi) & 7;
                for (;;) {
                    if (tid_now(wid_s) == 0) *slot = (int)__hip_atomic_fetch_add(qctr + 16 * xq, 1u, __ATOMIC_RELAXED, __HIP_MEMORY_SCOPE_AGENT);
                    __syncthreads();
                    const int u = __builtin_amdgcn_readfirstlane(*slot);
                    __syncthreads();
                    if (u >= 64) break;
                    const int bh = xq * 4 + (u >> 4), qb = u & 15, b = bh >> 2, h = bh & 3; const size_t r0 = (size_t)b * SEQ + qb * 256;
#ifndef NO_ATTN
                    att::attn_unit(Qb + r0 * 768 + h * 192, Kb + (size_t)b * SEQ * 768 + h * 192, Vb + (size_t)b * SEQ * 512 + h * 128, GA + r0 * 512 + h * 128, Y + r0 * 1024 + h * 128, SEQ, (char*)lds, wid_s);
#endif
                }
            }
                { unsigned* pctr = (unsigned*)(ws + WS_END + 3584) + l * 16; const float* psrc = KP->p + (size_t)l * T * 256; bf16_t* PBl = (bf16_t*)(ws + WS_PB) + (size_t)l * T * 256;
                  for (;;) {
                    if (tid_now(wid_s) == 0) *slot = (int)__hip_atomic_fetch_add(pctr, 1u, __ATOMIC_RELAXED, __HIP_MEMORY_SCOPE_AGENT);
                    __syncthreads();
                    const int ch = __builtin_amdgcn_readfirstlane(*slot);
                    __syncthreads();
                    if (ch >= 64) break;
                    const size_t base = (size_t)ch * (T * 256 / 64) + (size_t)tid_now(wid_s) * 8;
#pragma unroll 1
                    for (int it = 0; it < 32; it += 4) { f32x4 a[4], b[4];
#pragma unroll
                        for (int t = 0; t < 4; ++t) { const size_t o = base + (size_t)(it + t) * 4096; a[t] = *(const f32x4*)(psrc + o); b[t] = *(const f32x4*)(psrc + o + 4); }
#pragma unroll
                        for (int t = 0; t < 4; ++t) { const size_t o = base + (size_t)(it + t) * 4096; *(u32x4*)(PBl + o) = pack8(a[t], b[t]); } }
                  } }
                if (l == 0) {
                    unsigned* wctr = (unsigned*)(ws + WS_END + 3840);
                    for (;;) {
                        if (tid_now(wid_s) == 0) *slot = (int)__hip_atomic_fetch_add(wctr, 1u, __ATOMIC_RELAXED, __HIP_MEMORY_SCOPE_AGENT);
                        __syncthreads();
                        const int ch = __builtin_amdgcn_readfirstlane(*slot);
                        __syncthreads();
                        if (ch >= 64) break;
                        const Params P = load_params(); conv_layer_weights(P, 1, (float*)lds, tid_now(wid_s), ch, 64);
                    }
                }
            }
        }
        grid_bar(l * 5 + 3, wid_s);
        {
            unsigned char* ws = KP->ws; unsigned char* wb = ws + WS_W + l * W_LSTRIDE;
            { EpiPP EP; EP.PPd = (bf16_t*)KP->out; run_gemm(lds, (const bf16_t*)(ws + WS_PB) + (size_t)l * T * 256, (const bf16_t*)(wb + WO_PP), 1024, 256, EP, wid_s); }
            EpiOut EO; EO.HIN = l == 0 ? KP->x : nullptr; EO.wsb = ws; run_gemm(lds, (const bf16_t*)(ws + WS_Y), (const bf16_t*)(wb + WO_OUT), 1024, 1024, EO, wid_s);
        }
        grid_bar(l * 5 + 4, wid_s);
        {
            unsigned char* ws = KP->ws; unsigned char* wb = ws + WS_W + l * W_LSTRIDE;
            EpiPle EG; EG.PPd = (const bf16_t*)KP->out; EG.wsb = ws; run_gemm(lds, (const bf16_t*)(ws + WS_XBB), (const bf16_t*)(wb + WO_PG), 1024, 1024, EG, wid_s);
        }
        grid_bar(l * 5 + 5, wid_s);
    }
    {
        const Params P = load_params(); const float* SSA = (const float*)(P.ws + WS_SSA); const bf16_t* XA = (const bf16_t*)(P.ws + WS_XBA);
        const int tid = tid_now(wid_s), lane = tid & 63, gw = (blockIdx.x * 512 + tid) >> 6, nw = (gridDim.x * 512) >> 6;
        f32x4 gn[4];
#pragma unroll
        for (int it = 0; it < 4; ++it) gn[it] = *(const f32x4*)(P.final_norm + it * 256 + lane * 4);
        for (int row = gw; row < T; row += nw) { float s = SSA[(size_t)row * 16 + (lane & 15)];
            s += shx(s, lane, 1); s += shx(s, lane, 2); s += shx(s, lane, 4); s += shx(s, lane, 8); const float r = rsqrtf(s * (1.f / 1024.f) + EPS);
#pragma unroll
            for (int it = 0; it < 4; ++it) { const size_t o = (size_t)row * 1024 + it * 256 + lane * 4; const f32x2 w = *(const f32x2*)(XA + o); const unsigned w0 = ((const unsigned*)&w)[0], w1 = ((const unsigned*)&w)[1];
                f32x4 v; v[0] = __builtin_bit_cast(float, w0 << 16); v[1] = __builtin_bit_cast(float, w0 & 0xffff0000u); v[2] = __builtin_bit_cast(float, w1 << 16); v[3] = __builtin_bit_cast(float, w1 & 0xffff0000u);
                *(f32x4*)(P.out + o) = v * r * gn[it]; } }
    }
}

extern "C" void kernel_launch(void* const* d_in, const int* in_sizes, int n_in, void* d_out, int out_size, void* d_ws, size_t ws_size, hipStream_t stream) {
    static int grid_blocks = 0;
    if (n_in != 19 || ws_size < WS_END + 4096) { fprintf(stderr, "kernel_launch: unexpected inputs (n_in %d, ws %zu)\n", n_in, ws_size); return; }
    if (!grid_blocks) {
        if (hipFuncSetAttribute((const void*)hymba_fwd, hipFuncAttributeMaxDynamicSharedMemorySize, LDS_BYTES) != hipSuccess) { fprintf(stderr, "hipFuncSetAttribute failed\n"); return; }
        int dev = 0, cus = 0, per_cu = 0; hipGetDevice(&dev); hipDeviceGetAttribute(&cus, hipDeviceAttributeMultiprocessorCount, dev);
        if (hipOccupancyMaxActiveBlocksPerMultiprocessor(&per_cu, (const void*)hymba_fwd, 512, LDS_BYTES) != hipSuccess || per_cu < 1) { fprintf(stderr, "occupancy query failed\n"); return; }
        grid_blocks = cus;
    }
    Params P{};
    P.x = (const float*)d_in[0]; P.p = (const float*)d_in[1]; P.pos = (const int*)d_in[2]; P.ln_mix = (const float*)d_in[3]; P.w_in = (const float*)d_in[4]; P.q_norm = (const float*)d_in[5];
    P.w_uq = (const float*)d_in[6]; P.kv_norm = (const float*)d_in[7]; P.w_ukv = (const float*)d_in[8]; P.wgf = (const float*)d_in[9]; P.bgf = (const float*)d_in[10]; P.wgb = (const float*)d_in[11];
    P.bgb = (const float*)d_in[12]; P.gla_norm = (const float*)d_in[13]; P.w_out = (const float*)d_in[14]; P.ple_norm = (const float*)d_in[15]; P.w_pg = (const float*)d_in[16]; P.w_pp = (const float*)d_in[17];
    P.final_norm = (const float*)d_in[18]; P.out = (float*)d_out; P.ws = (unsigned char*)d_ws;
    if (hipMemsetAsync((char*)d_ws + WS_END, 0, 4096, stream) != hipSuccess) { fprintf(stderr, "memset failed\n"); return; }
    void* args[] = {&P};
    hipError_t e = hipLaunchCooperativeKernel((const void*)hymba_fwd, dim3(grid_blocks), dim3(512), args, LDS_BYTES, stream);
    if (e != hipSuccess) fprintf(stderr, "cooperative launch failed: %s (grid %d)\n", hipGetErrorString(e), grid_blocks);
}
```

```cpp
#include <hip/hip_runtime.h>
#include <hip/hip_cooperative_groups.h>
#include <cstdio>
#include <cstdint>
namespace cg = cooperative_groups;

__device__ __forceinline__ int tid_now(int wid_s) { int l; asm volatile("v_mbcnt_lo_u32_b32 %0, -1, 0\n\tv_mbcnt_hi_u32_b32 %0, -1, %0" : "=v"(l)); return (wid_s << 6) | l; }
__device__ __forceinline__ float shx(float v, int lane, int mask) { return __builtin_bit_cast(float, __builtin_amdgcn_ds_bpermute((lane ^ mask) << 2, __builtin_bit_cast(int, v))); }
namespace pg8 {
#define PG8_LAS __attribute__((address_space(3)))
typedef unsigned short bf16_t;
typedef short bf16x8 __attribute__((ext_vector_type(8)));
typedef float f32x4 __attribute__((ext_vector_type(4)));
typedef unsigned u32x4 __attribute__((ext_vector_type(4)));
constexpr int BM = 256, BK = 64, HALF = 128, HTB = HALF * BK * 2  , STAGE_BYTES = 8 * HTB, NXCD = 8, WGM = 8;

__host__ __device__ __forceinline__ int lds_byte(int r, int c) { const int st = (r >> 4) * 2 + (c >> 5), rr = r & 15, cc = c & 31, ob = rr * 64 + cc * 2; return st * 1024 + (ob ^ (((ob >> 9) & 1) << 5)); }
__host__ __device__ __forceinline__ void stage_rc(int b, int& R, int& C) { const int st = b / 1024, sb = b % 1024, swz = sb ^ (((sb >> 9) & 1) << 5); R = (st >> 1) * 16 + swz / 64; C = (st & 1) * 32 + (swz % 64) / 2; }
__host__ __device__ __forceinline__ int perm32(int rho) { const int n = rho >> 4, i = rho & 15; return 8 * (i >> 2) + 4 * n + (i & 3); }

struct Unit { int pm, pn; };
struct Gemm { const bf16_t* A; const bf16_t* Bt; int M, N, K; };

struct StaticOrder {
    int nM, nN, nwg, G, c;
    __host__ __device__ void init(int M, int N, int G_, int c_) { nM = M / BM; nN = N / BM; nwg = nM * nN; G = G_; c = c_; }
    __host__ __device__ bool next(int i, Unit& u) const {
        const long L = (long)i * G + c; if (L >= nwg) return false;
        int wgid = (int)L; { const int q = nwg / NXCD, r = nwg % NXCD, xcd = wgid % NXCD, off = wgid / NXCD; wgid = (xcd < r ? xcd * (q + 1) : r * (q + 1) + (xcd - r) * q) + off; }
        const int nig = WGM * nN, gid = wgid / nig, fm = gid * WGM, gsz = (nM - fm) < WGM ? (nM - fm) : WGM;
        u.pm = fm + ((wgid % nig) % gsz); u.pn = (wgid % nig) / gsz; return true;
    }
    __device__ __forceinline__ void a_ready(const Unit&) const {}
    __device__ __forceinline__ void done(const Unit&) const {}
};
__device__ __forceinline__ unsigned cvt_pk_bf16(float lo, float hi) { unsigned r; asm volatile("v_cvt_pk_bf16_f32 %0, %1, %2" : "=v"(r) : "v"(lo), "v"(hi)); return r; }
template <class Epi, class Sched, bool ALIGN_EPI = false, bool SP2 = false>
__device__ __forceinline__ void gemm_phase(PG8_LAS unsigned char* lds, const Gemm g, const Sched& S, const Epi& E, int wid_s) {
    int widl_ = wid_s; asm volatile("" : "+s"(widl_));
    const int tid = tid_now(widl_), wid = widl_, lane = tid & 63, wr = wid >> 2, wc = wid & 3, fr = lane & 15, fq = lane >> 4;
    const int K = g.K, nt = K / BK;
    unsigned voffA[2], voffB[2];
#pragma unroll
    for (int i = 0; i < 2; ++i) { int R, C; stage_rc(tid * 16 + i * 8192, R, C); const int Rb = Epi::PERM ? ((R & ~31) + perm32(R & 31)) : R;
        voffA[i] = (unsigned)(R * K + C) * 2u; voffB[i] = (unsigned)(Rb * K + C) * 2u; }
    const size_t kstep = (size_t)(BK * 2);
    const size_t hstep = (size_t)HALF * K * 2;
    const size_t tstep = 2 * hstep;
    const unsigned ldsw = (unsigned)wid * 1024u;
    const int aoff = lds_byte(wr * 64 + fr, fq * 8), boff = lds_byte(wc * 32 + fr, fq * 8);
#define PG8_SA(b, h) (((b) * 2 + (h)) * HTB)
#define PG8_SB(b, h) ((4 + (b) * 2 + (h)) * HTB)
#define PG8_STAGE(bufoff, gbase, voff) do { _Pragma("unroll") for (int _i = 0; _i < 2; ++_i) \
        __builtin_amdgcn_global_load_lds((const unsigned*)((const char*)(gbase) + (voff)[_i]), (PG8_LAS unsigned*)(lds + (bufoff) + ldsw + _i * 8192), 16, 0, 0); } while (0)
#define PG8_LDA(dst, b, h) do { _Pragma("unroll") for (int m = 0; m < 4; ++m) _Pragma("unroll") for (int k = 0; k < 2; ++k) dst[m][k] = *(const PG8_LAS bf16x8*)(lds + PG8_SA(b, h) + aoff + m * 2048 + k * 1024); } while (0)
#define PG8_LDB(dst, b, h) do { _Pragma("unroll") for (int n = 0; n < 2; ++n) _Pragma("unroll") for (int k = 0; k < 2; ++k) dst[n][k] = *(const PG8_LAS bf16x8*)(lds + PG8_SB(b, h) + boff + n * 2048 + k * 1024); } while (0)
#define PG8_MMA(ai, bj, At, Bt) do { __builtin_amdgcn_s_setprio(1); _Pragma("unroll") for (int m = 0; m < 4; ++m) _Pragma("unroll") for (int n = 0; n < 2; ++n) _Pragma("unroll") for (int k = 0; k < 2; ++k) \
        acc[ai][bj][m][n] = __builtin_amdgcn_mfma_f32_16x16x32_bf16(Bt[n][k], At[m][k], acc[ai][bj][m][n], 0, 0, 0); __builtin_amdgcn_s_setprio(0); } while (0)
#define PG8_WAIT_V(n) asm volatile("s_waitcnt vmcnt(" #n ")" ::: "memory")
#define PG8_WAIT_L(n) asm volatile("s_waitcnt lgkmcnt(" #n ")" ::: "memory")
#define PG8_BAR __builtin_amdgcn_s_barrier()
#define PG8_SCHED __builtin_amdgcn_sched_barrier(0)
    Unit cur, nxt; int ui = 0;
    if (!S.next(0, cur)) return;
    f32x4 acc[2][2][4][2];
#pragma unroll
    for (int a = 0; a < 2; ++a)
#pragma unroll
        for (int b = 0; b < 2; ++b)
#pragma unroll
            for (int m = 0; m < 4; ++m)
#pragma unroll
                for (int n = 0; n < 2; ++n) acc[a][b][m][n] = (f32x4){0.f, 0.f, 0.f, 0.f};
    bf16x8 At[4][2], B0[2][2], B1[2][2];
    const char* cA = (const char*)g.A + (size_t)cur.pm * tstep; const char* cB = (const char*)g.Bt + (size_t)cur.pn * tstep;
    S.a_ready(cur);
    if constexpr (SP2) {
        PG8_STAGE(PG8_SB(0, 0), cB, voffB); PG8_STAGE(PG8_SB(0, 1), cB + hstep, voffB); PG8_STAGE(PG8_SA(0, 0), cA, voffA); PG8_STAGE(PG8_SA(0, 1), cA + hstep, voffA);
        if (wr == 1) PG8_BAR;
        PG8_WAIT_V(2); PG8_BAR;
        PG8_STAGE(PG8_SB(1, 0), cB + kstep, voffB); PG8_STAGE(PG8_SA(1, 0), cA + kstep, voffA); PG8_STAGE(PG8_SB(1, 1), cB + hstep + kstep, voffB);
        PG8_WAIT_V(6); PG8_BAR;
    } else {
        PG8_STAGE(PG8_SB(0, 0), cB, voffB); PG8_STAGE(PG8_SA(0, 0), cA, voffA); PG8_STAGE(PG8_SB(0, 1), cB + hstep, voffB); PG8_STAGE(PG8_SA(0, 1), cA + hstep, voffA);
        if (wr == 1) PG8_BAR;
        PG8_WAIT_V(4); PG8_BAR;
        PG8_STAGE(PG8_SB(1, 0), cB + kstep, voffB); PG8_STAGE(PG8_SA(1, 0), cA + kstep, voffA); PG8_STAGE(PG8_SB(1, 1), cB + hstep + kstep, voffB);
        PG8_WAIT_V(6); PG8_BAR;
    }
    for (;;) {
        const bool has_next = S.next(ui + 1, nxt);
        const char* nA = has_next ? (const char*)g.A + (size_t)nxt.pm * tstep : cA; const char* nB = has_next ? (const char*)g.Bt + (size_t)nxt.pn * tstep : cB;
        for (int t = 0; t < nt; t += 2) {
            const bool last = (t == nt - 2);
            const char* a1 = cA + (size_t)(t + 1) * kstep;
            const char* a2 = last ? nA : cA + (size_t)(t + 2) * kstep; const char* b2 = last ? nB : cB + (size_t)(t + 2) * kstep;
            const char* a3 = a2 + kstep; const char* b3 = b2 + kstep;
            if (last && has_next) S.a_ready(nxt);
            if constexpr (SP2) {
            PG8_LDB(B0, 0, 0); PG8_LDB(B1, 0, 1); PG8_SCHED; PG8_LDA(At, 0, 0); PG8_STAGE(PG8_SA(1, 1), a1 + hstep, voffA);
            PG8_WAIT_V(8); PG8_WAIT_L(0); PG8_BAR; PG8_MMA(0, 0, At, B0); PG8_MMA(0, 1, At, B1); PG8_BAR; PG8_SCHED;
            PG8_LDA(At, 0, 1); PG8_STAGE(PG8_SB(0, 0), b2, voffB); PG8_STAGE(PG8_SB(0, 1), b2 + hstep, voffB); PG8_STAGE(PG8_SA(0, 0), a2, voffA);
            PG8_WAIT_V(8); PG8_WAIT_L(0); PG8_BAR; PG8_MMA(1, 0, At, B0); PG8_MMA(1, 1, At, B1); PG8_BAR; PG8_SCHED;
            PG8_LDB(B0, 1, 0); PG8_LDB(B1, 1, 1); PG8_SCHED; PG8_LDA(At, 1, 0); PG8_STAGE(PG8_SA(0, 1), a2 + hstep, voffA);
            PG8_WAIT_V(8); PG8_WAIT_L(0); PG8_BAR; PG8_MMA(0, 0, At, B0); PG8_MMA(0, 1, At, B1); PG8_BAR; PG8_SCHED;
            PG8_LDA(At, 1, 1); PG8_STAGE(PG8_SB(1, 0), b3, voffB); PG8_STAGE(PG8_SB(1, 1), b3 + hstep, voffB); PG8_STAGE(PG8_SA(1, 0), a3, voffA);
            PG8_WAIT_V(8); PG8_WAIT_L(0); PG8_BAR; PG8_MMA(1, 0, At, B0); PG8_MMA(1, 1, At, B1); PG8_BAR; PG8_SCHED;
            } else {
            PG8_LDB(B0, 0, 0); PG8_SCHED; PG8_LDA(At, 0, 0); PG8_STAGE(PG8_SA(1, 1), a1 + hstep, voffA);
            PG8_WAIT_L(8); PG8_BAR; PG8_WAIT_L(0); PG8_MMA(0, 0, At, B0); PG8_BAR; PG8_SCHED;
            PG8_LDB(B1, 0, 1); PG8_STAGE(PG8_SB(0, 0), b2, voffB);
            PG8_BAR; PG8_WAIT_L(0); PG8_MMA(0, 1, At, B1); PG8_BAR;
            PG8_LDA(At, 0, 1); PG8_STAGE(PG8_SA(0, 0), a2, voffA);
            PG8_BAR; PG8_WAIT_L(0); PG8_MMA(1, 0, At, B0); PG8_BAR; PG8_SCHED;
            PG8_STAGE(PG8_SB(0, 1), b2 + hstep, voffB);
            PG8_WAIT_V(6); PG8_BAR; PG8_MMA(1, 1, At, B1); PG8_BAR;
            PG8_LDB(B0, 1, 0); PG8_SCHED; PG8_LDA(At, 1, 0); PG8_STAGE(PG8_SA(0, 1), a2 + hstep, voffA);
            PG8_WAIT_L(8); PG8_BAR; PG8_WAIT_L(0); PG8_MMA(0, 0, At, B0); PG8_BAR; PG8_SCHED;
            PG8_LDB(B1, 1, 1); PG8_STAGE(PG8_SB(1, 0), b3, voffB);
            PG8_BAR; PG8_WAIT_L(0); PG8_MMA(0, 1, At, B1); PG8_BAR;
            PG8_LDA(At, 1, 1); PG8_STAGE(PG8_SA(1, 0), a3, voffA);
            PG8_BAR; PG8_WAIT_L(0); PG8_MMA(1, 0, At, B0); PG8_BAR; PG8_SCHED;
            PG8_STAGE(PG8_SB(1, 1), b3 + hstep, voffB);
            PG8_WAIT_V(6); PG8_BAR; PG8_MMA(1, 1, At, B1); PG8_BAR;
            }
        }
        if constexpr (ALIGN_EPI) { if (wr == 0) PG8_BAR; }
        if constexpr (!Epi::AFTER_DRAIN) { E(acc, cur, wr, wc, fr, fq); S.done(cur); }
        if (!has_next) break;
#pragma unroll
        for (int a = 0; a < 2; ++a)
#pragma unroll
            for (int b = 0; b < 2; ++b)
#pragma unroll
                for (int m = 0; m < 4; ++m)
#pragma unroll
                    for (int n = 0; n < 2; ++n) acc[a][b][m][n] = (f32x4){0.f, 0.f, 0.f, 0.f};
        cur = nxt; cA = nA; cB = nB; ++ui;
        if constexpr (ALIGN_EPI) { if (wr == 1) PG8_BAR; }
    }
    PG8_WAIT_V(0);
    if constexpr (!ALIGN_EPI) { if (wr == 0) PG8_BAR; }
    PG8_BAR;
    if constexpr (Epi::AFTER_DRAIN) { E.fused(acc, cur, wr, wc, fr, fq, lds, wid, lane); S.done(cur); }
#undef PG8_SA
#undef PG8_SB
#undef PG8_STAGE
#undef PG8_LDA
#undef PG8_LDB
#undef PG8_MMA
#undef PG8_WAIT_V
#undef PG8_WAIT_L
#undef PG8_BAR
#undef PG8_SCHED
}
}

using pg8::bf16_t; using pg8::bf16x8; using pg8::f32x4; using pg8::u32x4; using pg8::cvt_pk_bf16;
typedef float f32x16 __attribute__((ext_vector_type(16)));
typedef short s16x4 __attribute__((ext_vector_type(4)));
typedef float f32x2 __attribute__((ext_vector_type(2)));
#define LAS3 __attribute__((address_space(3)))

constexpr int T = 32768, SEQ = 4096, DM = 1024, DIN = 2784, DINP = 2816;
constexpr float EPS = 1e-6f;
constexpr size_t MiB = 1u << 20;
constexpr size_t WS_W = 0, W_LSTRIDE = 12 * MiB, WO_IN = 0, WO_UQ = 6 * MiB, WO_UKV = 7 * MiB, WO_PP = 7 * MiB + 512 * 1024, WO_OUT = 8 * MiB, WO_PG = 10 * MiB;
constexpr size_t WS_ROPE = 24 * MiB, WS_SSA = 32 * MiB, WS_SSB = 34 * MiB, WS_SSC = 36 * MiB, WS_XBA = 40 * MiB, WS_PB = 104 * MiB;
constexpr size_t WS_CQ = 136 * MiB, WS_CKV = 160 * MiB, WS_OB = 136 * MiB  ;
constexpr size_t WS_GQ = 176 * MiB, WS_GK = 192 * MiB, WS_LR = 208 * MiB, WS_GV = 210 * MiB, WS_GA = 242 * MiB, WS_GG = 274 * MiB;
constexpr size_t WS_Q = 306 * MiB, WS_K = 354 * MiB, WS_V = 402 * MiB, WS_XBB = 306 * MiB  , WS_PP = 370 * MiB  ;
constexpr size_t WS_Y = 434 * MiB, WS_END = 498 * MiB;

struct Params {
    const float *x, *p; const int* pos;
    const float *ln_mix, *w_in, *q_norm, *w_uq, *kv_norm, *w_ukv, *wgf, *bgf, *wgb, *bgb, *gla_norm, *w_out, *ple_norm, *w_pg, *w_pp, *final_norm;
    float* out; unsigned char* ws;
};

__device__ __forceinline__ unsigned f2bf(float f) { unsigned u = __builtin_bit_cast(unsigned, f); return (u + 0x7fffu + ((u >> 16) & 1u)) >> 16; }
__device__ __forceinline__ float bf2f(unsigned short h) { return __builtin_bit_cast(float, (unsigned)h << 16); }
__device__ __forceinline__ u32x4 pack8(f32x4 a, f32x4 b) { u32x4 w; w.x = cvt_pk_bf16(a[0], a[1]); w.y = cvt_pk_bf16(a[2], a[3]); w.z = cvt_pk_bf16(b[0], b[1]); w.w = cvt_pk_bf16(b[2], b[3]); return w; }
__device__ __forceinline__ float dot4(f32x4 a) { return (a[0] * a[0] + a[1] * a[1]) + (a[2] * a[2] + a[3] * a[3]); }
__device__ __forceinline__ float sigmoidf_(float v) { return __builtin_amdgcn_rcpf(1.f + __expf(-v)); }
__device__ __forceinline__ f32x4 silu4(f32x4 v) { f32x4 o; o[0] = v[0] * sigmoidf_(v[0]); o[1] = v[1] * sigmoidf_(v[1]); o[2] = v[2] * sigmoidf_(v[2]); o[3] = v[3] * sigmoidf_(v[3]); return o; }

__device__ __forceinline__ int wmap(int mode, int n, float& sc) {
    sc = 1.f;
    if (mode == 0) return n;
    if (mode == 1) {
        if (n < 640) return n;
        if (n < 768) { const int w = n - 640; if (w < 64) { const int i = w >> 1, s = w & 1; return 640 + (s ? 32 + i : i); } if (w < 80) return 2240 + (w - 64); if (w < 96) return 2256 + (w - 80); return -1; }
        if (n < 1280) return 704 + (n - 768);
        if (n < 1536) { sc = 0.125f; return 1216 + (n - 1280); }
        if (n < 1792) return 1472 + (n - 1536);
        if (n < 2304) return 1728 + (n - 1792);
        return 2272 + (n - 2304);
    }
    if (mode == 2) {
        const int h = n / 192, j = n % 192; if (j < 128) return n; const int w = j - 128, i = w >> 1, s = w & 1; return h * 192 + 128 + (s ? 32 + i : i);
    }
    if (n < 512) { const int h = n >> 7, j = n & 127; return h * 256 + j; }
    { const int m = n - 512, h = m >> 7, j = m & 127; return h * 256 + 128 + j; }
}
__device__ __forceinline__ void conv_w(const float* __restrict__ src, int K, int Nsrc, bf16_t* __restrict__ dst, int Ndst, const float* __restrict__ gain, int mode, int gtid, int gsz) {
    const int total = Ndst * (K / 8);
    for (int idx = gtid; idx < total; idx += gsz) {
        const int n = idx % Ndst, k0 = (idx / Ndst) * 8; float sc; const int s = wmap(mode, n, sc);
        float v[8];
#pragma unroll
        for (int j = 0; j < 8; ++j) v[j] = (s >= 0) ? src[(size_t)(k0 + j) * Nsrc + s] * (gain ? gain[k0 + j] : 1.f) * sc : 0.f;
        u32x4 w; w.x = cvt_pk_bf16(v[0], v[1]); w.y = cvt_pk_bf16(v[2], v[3]); w.z = cvt_pk_bf16(v[4], v[5]); w.w = cvt_pk_bf16(v[6], v[7]);
        *(u32x4*)(dst + (size_t)n * K + k0) = w;
    }
}
__device__ __forceinline__ void conv_w_tiled(const float* __restrict__ src, int K, int Nsrc, bf16_t* __restrict__ dst, int Ndst, const float* __restrict__ gain, int mode, float* tile, int tid, int first, int stride) {
    const int ntn = Ndst >> 6, nt = ntn * (K >> 6);
    const int nn = tid & 63, kq = tid >> 6, nn2 = tid >> 3, kseg = tid & 7;
    for (int t = first; t < nt; t += stride) {
        const int n0 = (t % ntn) * 64, k0 = (t / ntn) * 64;
        float sc; const int sidx = wmap(mode, n0 + nn, sc);
        float v[8];
#pragma unroll
        for (int i = 0; i < 8; ++i) v[i] = (sidx >= 0) ? src[(size_t)(k0 + kq + 8 * i) * Nsrc + sidx] * sc : 0.f;
#pragma unroll
        for (int i = 0; i < 8; ++i) tile[(kq + 8 * i) * 65 + nn] = v[i];
        __syncthreads();
        float o[8];
#pragma unroll
        for (int j = 0; j < 8; ++j) o[j] = tile[(kseg * 8 + j) * 65 + nn2] * (gain ? gain[k0 + kseg * 8 + j] : 1.f);
        u32x4 w; w.x = cvt_pk_bf16(o[0], o[1]); w.y = cvt_pk_bf16(o[2], o[3]); w.z = cvt_pk_bf16(o[4], o[5]); w.w = cvt_pk_bf16(o[6], o[7]);
        *(u32x4*)(dst + (size_t)(n0 + nn2) * K + k0 + kseg * 8) = w;
        __syncthreads();
    }
}
__device__ __forceinline__ void conv_layer_weights(const Params& P, int l, float* tile, int tid, int first, int stride) {
    unsigned char* wb = P.ws + WS_W + l * W_LSTRIDE;
    conv_w_tiled(P.w_in + (size_t)l * DM * DIN, 1024, DIN, (bf16_t*)(wb + WO_IN), DINP, P.ln_mix + l * 1024, 1, tile, tid, first, stride);
    conv_w_tiled(P.w_uq + (size_t)l * 384 * 768, 384, 768, (bf16_t*)(wb + WO_UQ), 768, P.q_norm + l * 384, 2, tile, tid, first, stride);
    conv_w_tiled(P.w_ukv + (size_t)l * 256 * 1024, 256, 1024, (bf16_t*)(wb + WO_UKV), 1024, P.kv_norm + l * 256, 3, tile, tid, first, stride);
    conv_w_tiled(P.w_pp + (size_t)l * 256 * 1024, 256, 1024, (bf16_t*)(wb + WO_PP), 1024, nullptr, 0, tile, tid, first, stride);
    conv_w_tiled(P.w_out + (size_t)l * 1024 * 1024, 1024, 1024, (bf16_t*)(wb + WO_OUT), 1024, nullptr, 0, tile, tid, first, stride);
    conv_w_tiled(P.w_pg + (size_t)l * 1024 * 1024, 1024, 1024, (bf16_t*)(wb + WO_PG), 1024, P.ple_norm + l * 1024, 0, tile, tid, first, stride);
}
__device__ __forceinline__ void prologue(const Params& P, int wid_s, float* tile) {
    const int tid = tid_now(wid_s); const int gtid = blockIdx.x * 512 + tid, gsz = gridDim.x * 512;
    unsigned char* ws = P.ws;
    conv_layer_weights(P, 0, tile, tid, blockIdx.x, gridDim.x);
    { f32x2* R = (f32x2*)(ws + WS_ROPE);
      for (int i = gtid; i < T * 32; i += gsz) { const int row = i >> 5, k = i & 31; const float inv = powf(10000.f, -(float)k / 32.f); const float ang = (float)P.pos[row] * inv;
        double rev = (double)ang * 0.15915494309189535; rev -= floor(rev); const float rf = (float)rev;
        f32x2 cs; cs.x = __builtin_amdgcn_cosf(rf); cs.y = __builtin_amdgcn_sinf(rf); R[i] = cs; } }
    { bf16_t* XB = (bf16_t*)(ws + WS_XBA); float* SS = (float*)(ws + WS_SSA); const int lane = tid & 63, gw = gtid >> 6, nw = gsz >> 6;
      for (int row = gw; row < T; row += nw) { float sacc = 0.f; f32x4 va[2], vb[2];
#pragma unroll
        for (int it = 0; it < 2; ++it) { const int col = it * 512 + lane * 8; va[it] = *(const f32x4*)(P.x + (size_t)row * 1024 + col); vb[it] = *(const f32x4*)(P.x + (size_t)row * 1024 + col + 4); }
#pragma unroll
        for (int it = 0; it < 2; ++it) { const int col = it * 512 + lane * 8; sacc += dot4(va[it]) + dot4(vb[it]); *(u32x4*)(XB + (size_t)row * 1024 + col) = pack8(va[it], vb[it]); }
#pragma unroll
        for (int o = 32; o >= 1; o >>= 1) sacc += shx(sacc, lane, o);
        if (lane < 16) SS[(size_t)row * 16 + lane] = (lane == 0) ? sacc : 0.f; } }
}

#define GAS1 __attribute__((address_space(1)))
__device__ __forceinline__ void gst16(void* p, u32x4 v) { *(GAS1 u32x4*)p = v; }
__device__ __forceinline__ void gst16f(void* p, f32x4 v) { *(GAS1 f32x4*)p = v; }
__device__ __forceinline__ void gst4f(void* p, float v) { *(GAS1 float*)p = v; }
__device__ __forceinline__ f32x4 gld16f(const void* p) { return *(const GAS1 f32x4*)p; }
__device__ __forceinline__ u32x4 gld16(const void* p) { return *(const GAS1 u32x4*)p; }
__device__ __forceinline__ void unpack8(u32x4 w, f32x4& a, f32x4& b) {
    a[0] = __builtin_bit_cast(float, w.x << 16); a[1] = __builtin_bit_cast(float, w.x & 0xffff0000u); a[2] = __builtin_bit_cast(float, w.y << 16); a[3] = __builtin_bit_cast(float, w.y & 0xffff0000u);
    b[0] = __builtin_bit_cast(float, w.z << 16); b[1] = __builtin_bit_cast(float, w.z & 0xffff0000u); b[2] = __builtin_bit_cast(float, w.w << 16); b[3] = __builtin_bit_cast(float, w.w & 0xffff0000u);
}
__device__ __forceinline__ void row_rstd(float (&rs)[2][4], const float* __restrict__ Pp, int stride, int off, int np, float invdim, int row0, int fq, int ln_) {
    f32x4 v[2][4];
#pragma unroll
    for (int ai = 0; ai < 2; ++ai)
#pragma unroll
        for (int m = 0; m < 4; ++m) v[ai][m] = (4 * fq < np) ? gld16f(Pp + (size_t)(row0 + ai * 128 + m * 16) * stride + off + 4 * fq) : (f32x4){0.f, 0.f, 0.f, 0.f};
#pragma unroll
    for (int ai = 0; ai < 2; ++ai)
#pragma unroll
        for (int m = 0; m < 4; ++m) { float s = (v[ai][m][0] + v[ai][m][1]) + (v[ai][m][2] + v[ai][m][3]);
            s += shx(s, ln_, 16); s += shx(s, ln_, 32); rs[ai][m] = rsqrtf(s * invdim + EPS); }
}
__device__ __forceinline__ void rope8(f32x4& v0, f32x4& v1, const f32x2* __restrict__ rp) {
    const f32x4 c01 = gld16f(rp), c23 = gld16f(rp + 2);
    f32x4 o0, o1;
    o0[0] = v0[0] * c01[0] - v0[1] * c01[1]; o0[1] = v0[0] * c01[1] + v0[1] * c01[0];
    o0[2] = v0[2] * c01[2] - v0[3] * c01[3]; o0[3] = v0[2] * c01[3] + v0[3] * c01[2];
    o1[0] = v1[0] * c23[0] - v1[1] * c23[1]; o1[1] = v1[0] * c23[1] + v1[1] * c23[0];
    o1[2] = v1[2] * c23[2] - v1[3] * c23[3]; o1[3] = v1[2] * c23[3] + v1[3] * c23[2];
    v0 = o0; v1 = o1;
}
struct Epi1 {
    static constexpr bool PERM = true, AFTER_DRAIN = false;
    unsigned char* wsb;
    __device__ __forceinline__ void operator()(const f32x4 (&acc)[2][2][4][2], const pg8::Unit& u, int wr, int wc, int fr, int fq) const {
        const int ln_ = tid_now(0) & 63; fr = ln_ & 15; fq = ln_ >> 4;
        unsigned char* ws = wsb; asm volatile("" : "+s"(ws));
        const float* SS = (const float*)(ws + WS_SSA); const f32x2* rope = (const f32x2*)(ws + WS_ROPE); float* SSC = (float*)(ws + WS_SSC);
        bf16_t* CQ = (bf16_t*)(ws + WS_CQ); bf16_t* CKV = (bf16_t*)(ws + WS_CKV); bf16_t* K = (bf16_t*)(ws + WS_K); bf16_t* LR = (bf16_t*)(ws + WS_LR); bf16_t* GA = (bf16_t*)(ws + WS_GA);
        bf16_t* GQ = (bf16_t*)(ws + WS_GQ); bf16_t* GK = (bf16_t*)(ws + WS_GK); bf16_t* GV = (bf16_t*)(ws + WS_GV); bf16_t* GG = (bf16_t*)(ws + WS_GG);
        const int row0 = u.pm * 256 + wr * 64 + fr; float rs[2][4]; row_rstd(rs, SS, 16, 0, 16, 1.f / 1024.f, row0, fq, ln_);
        const int hc = wc * 32 + fq * 8;
#pragma unroll
        for (int bj = 0; bj < 2; ++bj) { const int hf = u.pn * 2 + bj;
#pragma unroll
            for (int ai = 0; ai < 2; ++ai)
#pragma unroll
                for (int m = 0; m < 4; ++m) { const size_t row = (size_t)(row0 + ai * 128 + m * 16); const float r = rs[ai][m];
                    f32x4 v0 = acc[ai][bj][m][0] * r, v1 = acc[ai][bj][m][1] * r;
                    if (hf < 5) { float ss = dot4(v0) + dot4(v1); ss += shx(ss, ln_, 16); ss += shx(ss, ln_, 32); const u32x4 w = pack8(v0, v1);
                        if (hf < 3) { gst16(CQ + row * 384 + hf * 128 + hc, w); if (fq == 0) gst4f(SSC + (row * 32 + hf * 4 + wc), ss); }
                        else { gst16(CKV + row * 256 + (hf - 3) * 128 + hc, w); if (fq == 0) gst4f(SSC + (row * 32 + 12 + (hf - 3) * 4 + wc), ss); } }
                    else if (hf == 5) {
                        if (wc < 2) { rope8(v0, v1, rope + row * 32 + (hc >> 1)); const u32x4 w = pack8(v0, v1);
#pragma unroll
                            for (int h = 0; h < 4; ++h) gst16(K + row * 768 + h * 192 + 128 + hc, w); }
                        else if (wc == 2) { gst16(LR + row * 32 + (hc - 64), pack8(v0, v1)); } }
                    else if (hf < 10) { gst16(GA + row * 512 + (hf - 6) * 128 + hc, pack8(silu4(v0), silu4(v1))); }
                    else if (hf < 12) { gst16(GQ + row * 256 + (hf - 10) * 128 + hc, pack8(v0, v1)); }
                    else if (hf < 14) { gst16(GK + row * 256 + (hf - 12) * 128 + hc, pack8(v0, v1)); }
                    else if (hf < 18) { gst16(GV + row * 512 + (hf - 14) * 128 + hc, pack8(v0, v1)); }
                    else { gst16(GG + row * 512 + (hf - 18) * 128 + hc, pack8(silu4(v0), silu4(v1))); }
                } }
    }
};
struct EpiQ {
    static constexpr bool PERM = true, AFTER_DRAIN = false;
    unsigned char* wsb;
    __device__ __forceinline__ void operator()(const f32x4 (&acc)[2][2][4][2], const pg8::Unit& u, int wr, int wc, int fr, int fq) const {
        const int ln_ = tid_now(0) & 63; fr = ln_ & 15; fq = ln_ >> 4;
        unsigned char* ws = wsb; asm volatile("" : "+s"(ws));
        const float* SSC = (const float*)(ws + WS_SSC); const f32x2* rope = (const f32x2*)(ws + WS_ROPE); bf16_t* Q = (bf16_t*)(ws + WS_Q);
        const int row0 = u.pm * 256 + wr * 64 + fr; float rs[2][4]; row_rstd(rs, SSC, 32, 0, 12, 1.f / 384.f, row0, fq, ln_);
        const int hc = wc * 32 + fq * 8;
#pragma unroll
        for (int bj = 0; bj < 2; ++bj) { const int hf = u.pn * 2 + bj, hm = hf % 3; const bool rw = (hm == 1 && wc < 2) || (hm == 2 && wc >= 2);
            const int col = hf * 128 + hc, i0 = ((col % 192) - 128) >> 1;
#pragma unroll
            for (int ai = 0; ai < 2; ++ai)
#pragma unroll
                for (int m = 0; m < 4; ++m) { const size_t row = (size_t)(row0 + ai * 128 + m * 16); const float r = rs[ai][m];
                    f32x4 v0 = acc[ai][bj][m][0] * r, v1 = acc[ai][bj][m][1] * r;
                    if (rw) rope8(v0, v1, rope + row * 32 + i0);
                    gst16(Q + row * 768 + col, pack8(v0, v1)); } }
    }
};
struct EpiKV {
    static constexpr bool PERM = true, AFTER_DRAIN = false;
    unsigned char* wsb;
    __device__ __forceinline__ void operator()(const f32x4 (&acc)[2][2][4][2], const pg8::Unit& u, int wr, int wc, int fr, int fq) const {
        const int ln_ = tid_now(0) & 63; fr = ln_ & 15; fq = ln_ >> 4;
        unsigned char* ws = wsb; asm volatile("" : "+s"(ws));
        const float* SSC = (const float*)(ws + WS_SSC); bf16_t* K = (bf16_t*)(ws + WS_K); bf16_t* V = (bf16_t*)(ws + WS_V);
        const int row0 = u.pm * 256 + wr * 64 + fr; float rs[2][4]; row_rstd(rs, SSC, 32, 12, 8, 1.f / 256.f, row0, fq, ln_);
        const int hc = wc * 32 + fq * 8;
#pragma unroll
        for (int bj = 0; bj < 2; ++bj) { const int hf = u.pn * 2 + bj;
#pragma unroll
            for (int ai = 0; ai < 2; ++ai)
#pragma unroll
                for (int m = 0; m < 4; ++m) { const size_t row = (size_t)(row0 + ai * 128 + m * 16); const float r = rs[ai][m];
                    const u32x4 w = pack8(acc[ai][bj][m][0] * r, acc[ai][bj][m][1] * r);
                    if (hf < 4) gst16(K + row * 768 + hf * 192 + hc, w); else gst16(V + row * 512 + (hf - 4) * 128 + hc, w); } }
    }
};
struct EpiOut {
    static constexpr bool PERM = true, AFTER_DRAIN = false;
    const float* HIN; unsigned char* wsb;
    template <bool F32IN> __device__ __forceinline__ void body(const f32x4 (&acc)[2][2][4][2], const pg8::Unit& u, int wr, int wc, int fr, int fq, int ln_, unsigned char* ws) const {
        bf16_t* XB = (bf16_t*)(ws + WS_XBB); const bf16_t* XA = (const bf16_t*)(ws + WS_XBA); float* SSo = (float*)(ws + WS_SSB);
        const int row0 = u.pm * 256 + wr * 64 + fr, hc = wc * 32 + fq * 8;
#pragma unroll
        for (int ai = 0; ai < 2; ++ai)
#pragma unroll
            for (int mp = 0; mp < 2; ++mp) {
                f32x4 ha[2][2], hb[2][2];
#pragma unroll
                for (int mm = 0; mm < 2; ++mm)
#pragma unroll
                    for (int bj = 0; bj < 2; ++bj) { const size_t o = (size_t)(row0 + ai * 128 + (mp * 2 + mm) * 16) * 1024 + u.pn * 256 + bj * 128 + hc;
                        if constexpr (F32IN) { ha[mm][bj] = gld16f(HIN + o); hb[mm][bj] = gld16f(HIN + o + 4); } else { ha[mm][bj] = __builtin_bit_cast(f32x4, gld16(XA + o)); } }
#pragma unroll
                for (int mm = 0; mm < 2; ++mm) { const int m = mp * 2 + mm; const size_t row = (size_t)(row0 + ai * 128 + m * 16); float ss = 0.f;
#pragma unroll
                    for (int bj = 0; bj < 2; ++bj) { const size_t o = row * 1024 + u.pn * 256 + bj * 128 + hc; f32x4 a, b;
                        if constexpr (F32IN) { a = ha[mm][bj]; b = hb[mm][bj]; } else unpack8(__builtin_bit_cast(u32x4, ha[mm][bj]), a, b);
                        const f32x4 v0 = acc[ai][bj][m][0] + a, v1 = acc[ai][bj][m][1] + b;
                        gst16(XB + o, pack8(v0, v1)); ss += dot4(v0) + dot4(v1); }
                    ss += shx(ss, ln_, 16); ss += shx(ss, ln_, 32); gst4f(SSo + (row * 16 + u.pn * 4 + wc), ss); }
            }
    }
    __device__ __forceinline__ void operator()(const f32x4 (&acc)[2][2][4][2], const pg8::Unit& u, int wr, int wc, int fr, int fq) const {
        const int ln_ = tid_now(0) & 63; fr = ln_ & 15; fq = ln_ >> 4;
        unsigned char* ws = wsb; asm volatile("" : "+s"(ws));
        if (HIN != nullptr) body<true>(acc, u, wr, wc, fr, fq, ln_, ws); else body<false>(acc, u, wr, wc, fr, fq, ln_, ws);
    }
};
struct EpiPP {
    static constexpr bool PERM = true, AFTER_DRAIN = false;
    bf16_t* PPd;
    __device__ __forceinline__ void operator()(const f32x4 (&acc)[2][2][4][2], const pg8::Unit& u, int wr, int wc, int fr, int fq) const {
        const int ln_ = tid_now(0) & 63; fr = ln_ & 15; fq = ln_ >> 4;
        bf16_t* PP = PPd; asm volatile("" : "+s"(PP));
        const int row0 = u.pm * 256 + wr * 64 + fr, hc = wc * 32 + fq * 8;
#pragma unroll
        for (int ai = 0; ai < 2; ++ai)
#pragma unroll
            for (int m = 0; m < 4; ++m)
#pragma unroll
                for (int bj = 0; bj < 2; ++bj) gst16(PP + (size_t)(row0 + ai * 128 + m * 16) * 1024 + u.pn * 256 + bj * 128 + hc, pack8(acc[ai][bj][m][0], acc[ai][bj][m][1]));
    }
};
struct EpiPle {
    static constexpr bool PERM = true, AFTER_DRAIN = false;
    const bf16_t* PPd; unsigned char* wsb;
    __device__ __forceinline__ void operator()(const f32x4 (&acc)[2][2][4][2], const pg8::Unit& u, int wr, int wc, int fr, int fq) const {
        const int ln_ = tid_now(0) & 63; fr = ln_ & 15; fq = ln_ >> 4;
        unsigned char* ws = wsb; asm volatile("" : "+s"(ws));
        const float* SSin = (const float*)(ws + WS_SSB); const bf16_t* PP = PPd; asm volatile("" : "+s"(PP)); const bf16_t* XH = (const bf16_t*)(ws + WS_XBB); bf16_t* XB = (bf16_t*)(ws + WS_XBA); float* SSo = (float*)(ws + WS_SSA);
        const int row0 = u.pm * 256 + wr * 64 + fr, hc = wc * 32 + fq * 8; float rs[2][4]; row_rstd(rs, SSin, 16, 0, 16, 1.f / 1024.f, row0, fq, ln_);
#pragma unroll
        for (int ai = 0; ai < 2; ++ai)
#pragma unroll
            for (int mp = 0; mp < 2; ++mp) {
                u32x4 pw[2][2], hw[2][2];
#pragma unroll
                for (int mm = 0; mm < 2; ++mm)
#pragma unroll
                    for (int bj = 0; bj < 2; ++bj) { const size_t o = (size_t)(row0 + ai * 128 + (mp * 2 + mm) * 16) * 1024 + u.pn * 256 + bj * 128 + hc; pw[mm][bj] = gld16(PP + o); hw[mm][bj] = gld16(XH + o); }
#pragma unroll
                for (int mm = 0; mm < 2; ++mm) { const int m = mp * 2 + mm; const size_t row = (size_t)(row0 + ai * 128 + m * 16); const float r = rs[ai][m]; float ss = 0.f;
#pragma unroll
                    for (int bj = 0; bj < 2; ++bj) { const size_t o = row * 1024 + u.pn * 256 + bj * 128 + hc;
                        f32x4 p0, p1, h0, h1; unpack8(pw[mm][bj], p0, p1); unpack8(hw[mm][bj], h0, h1);
                        const f32x4 a0 = acc[ai][bj][m][0] * r, a1 = acc[ai][bj][m][1] * r; f32x4 v0, v1;
#pragma unroll
                        for (int e = 0; e < 4; ++e) { v0[e] = h0[e] + sigmoidf_(a0[e]) * p0[e]; v1[e] = h1[e] + sigmoidf_(a1[e]) * p1[e]; }
                        gst16(XB + o, pack8(v0, v1));
                        ss += dot4(v0) + dot4(v1); }
                    ss += shx(ss, ln_, 16); ss += shx(ss, ln_, 32); gst4f(SSo + (row * 16 + u.pn * 4 + wc), ss); }
            }
    }
};
namespace att {
constexpr int NW = 8, QBLK = 32, KVBLK = 64, LDQ = 768, LDK = 768, LDV = 512;
constexpr float SCALE = 0.07216878364870322f;
constexpr float THR = 8.f;
constexpr int SHM_V = 64 * 128 * 2, SHM_K = 64 * 400, SHM_ATTN = 2 * SHM_V + 2 * SHM_K + NW * 64 * 4;
#define KSWZ(row, colB) ((row) * 400 + (colB))
#define SBAR() __builtin_amdgcn_sched_barrier(0)
__device__ __forceinline__ int crow(int r, int hi) { return (r & 3) + 8 * (r >> 2) + 4 * hi; }
__device__ __forceinline__ unsigned cvtpk(float lo, float hi) { unsigned r; asm volatile("v_cvt_pk_bf16_f32 %0, %1, %2" : "=v"(r) : "v"(lo), "v"(hi)); return r; }
__device__ __forceinline__ void partialSM(f32x16& p0, f32x16& p1, float& m_reg, float& mn, float& alpha) {
  constexpr float C = SCALE * 1.4426950408889634f;
  float pmax = p0[0];
#pragma unroll
  for (int r = 1; r < 16; ++r) pmax = fmaxf(pmax, p0[r]);
#pragma unroll
  for (int r = 0; r < 16; ++r) pmax = fmaxf(pmax, p1[r]);
  { auto rr = __builtin_amdgcn_permlane32_swap(__float_as_uint(pmax), __float_as_uint(pmax), false, false);
    pmax = fmaxf(__uint_as_float(rr[0]), __uint_as_float(rr[1])); }
  if (__builtin_expect(__all(pmax - m_reg <= THR / SCALE), 1)) { mn = m_reg; alpha = 1.f; }
  else { mn = fmaxf(m_reg, pmax); alpha = __builtin_amdgcn_exp2f((m_reg - mn) * C); m_reg = mn; }
  float mnC = -mn * C;
#pragma unroll
  for (int r = 0; r < 16; ++r) p0[r] = fmaf(p0[r], C, mnC);
#pragma unroll
  for (int r = 0; r < 16; ++r) p1[r] = fmaf(p1[r], C, mnC);
#pragma unroll
  for (int r = 0; r < 16; ++r) p0[r] = __builtin_amdgcn_exp2f(p0[r]);
}
__device__ __forceinline__ void finishSM(f32x16& p0, f32x16& p1, float alpha, float& l_reg, bf16x8& pa0, bf16x8& pa1, bf16x8& pa2, bf16x8& pa3) {
#pragma unroll
  for (int r = 0; r < 16; ++r) p1[r] = __builtin_amdgcn_exp2f(p1[r]);
  float ps = 0;
#pragma unroll
  for (int r = 0; r < 16; ++r) ps += p0[r];
#pragma unroll
  for (int r = 0; r < 16; ++r) ps += p1[r];
  { auto rr = __builtin_amdgcn_permlane32_swap(__float_as_uint(ps), __float_as_uint(ps), false, false);
    ps = __uint_as_float(rr[0]) + __uint_as_float(rr[1]); }
  l_reg = l_reg * alpha + ps;
#define PK4(P, BASE, OUT) do { unsigned a0 = cvtpk(P[BASE + 0], P[BASE + 1]), a1 = cvtpk(P[BASE + 2], P[BASE + 3]);   \
    unsigned b0 = cvtpk(P[BASE + 4], P[BASE + 5]), b1 = cvtpk(P[BASE + 6], P[BASE + 7]);                              \
    auto r0 = __builtin_amdgcn_permlane32_swap(a0, b0, false, false); auto r1 = __builtin_amdgcn_permlane32_swap(a1, b1, false, false); \
    u32x4 w = {r0[0], r1[0], r0[1], r1[1]}; OUT = *reinterpret_cast<bf16x8*>(&w); } while (0)
  PK4(p0, 0, pa0); PK4(p0, 8, pa1); PK4(p1, 0, pa2); PK4(p1, 8, pa3);
#undef PK4
}
__device__ __forceinline__ void qkt(f32x16& p0, f32x16& p1, const char* Ks, const bf16x8* qr, int r32, int hi) {
  p0 = f32x16{}; p1 = f32x16{};
  const char* kb_ = Ks + r32 * 400 + hi * 16;
#pragma unroll
  for (int d0 = 0; d0 < 12; ++d0) {
    bf16x8 b0 = *reinterpret_cast<const bf16x8*>(kb_ + d0 * 32);
    bf16x8 b1 = *reinterpret_cast<const bf16x8*>(kb_ + 32 * 400 + d0 * 32);
    p0 = __builtin_amdgcn_mfma_f32_32x32x16_bf16(b0, qr[d0], p0, 0, 0, 0);
    p1 = __builtin_amdgcn_mfma_f32_32x32x16_bf16(b1, qr[d0], p1, 0, 0, 0); }
}
__device__ __forceinline__ int v_st(int k, int c) { const int kk = (k & ~0xC) | ((k & 4) << 1) | ((k & 8) >> 1); return ((kk >> 3) * 4 + (c >> 5)) * 512 + ((kk & 7) * 32 + (c & 31)) * 2; }
__device__ __forceinline__ int v_rd_base(int lane) { return ((lane & 3) << 3) | (((lane >> 2) & 3) << 6) | (((lane >> 4) & 1) << 5) | (((lane >> 5) & 1) << 8); }
constexpr int v_rd_off(int d0, int ks, int half) { return d0 * 512 + ks * 4096 + half * 2048; }
template <int OFF> __device__ __forceinline__ s16x4 tr_read(int vb) {
  s16x4 r; asm volatile("ds_read_b64_tr_b16 %0, %1 offset:%2" : "=&v"(r) : "v"(vb), "i"(OFF) : "memory"); return r;
}
template <int D0> __device__ __forceinline__ void pv_one(f32x16& od, int vb, bf16x8 pa0, bf16x8 pa1, bf16x8 pa2, bf16x8 pa3) {
  const s16x4 l0 = tr_read<v_rd_off(D0, 0, 0)>(vb), h0 = tr_read<v_rd_off(D0, 0, 1)>(vb), l1 = tr_read<v_rd_off(D0, 1, 0)>(vb), h1 = tr_read<v_rd_off(D0, 1, 1)>(vb);
  const s16x4 l2 = tr_read<v_rd_off(D0, 2, 0)>(vb), h2 = tr_read<v_rd_off(D0, 2, 1)>(vb), l3 = tr_read<v_rd_off(D0, 3, 0)>(vb), h3 = tr_read<v_rd_off(D0, 3, 1)>(vb);
  asm volatile("s_waitcnt lgkmcnt(0)" ::: "memory"); SBAR();
#define PK(L, H) (bf16x8){L[0], L[1], L[2], L[3], H[0], H[1], H[2], H[3]}
  od = __builtin_amdgcn_mfma_f32_32x32x16_bf16(pa0, PK(l0, h0), od, 0, 0, 0);
  od = __builtin_amdgcn_mfma_f32_32x32x16_bf16(pa1, PK(l1, h1), od, 0, 0, 0);
  od = __builtin_amdgcn_mfma_f32_32x32x16_bf16(pa2, PK(l2, h2), od, 0, 0, 0);
  od = __builtin_amdgcn_mfma_f32_32x32x16_bf16(pa3, PK(l3, h3), od, 0, 0, 0);
#undef PK
}
__device__ __forceinline__ void pv_d0(f32x16* o, int vb, bf16x8 pa0, bf16x8 pa1, bf16x8 pa2, bf16x8 pa3) {
  pv_one<0>(o[0], vb, pa0, pa1, pa2, pa3); pv_one<1>(o[1], vb, pa0, pa1, pa2, pa3); pv_one<2>(o[2], vb, pa0, pa1, pa2, pa3); pv_one<3>(o[3], vb, pa0, pa1, pa2, pa3);
}
__device__ __forceinline__ void attn_unit(const bf16_t* __restrict__ Qb, const bf16_t* __restrict__ Kh, const bf16_t* __restrict__ Vh,
                                          const bf16_t* __restrict__ Gb, bf16_t* __restrict__ Ob, int seq, char* lds, int wid_s) {
  const int tid = tid_now(wid_s), wid = tid >> 6, lane = tid & 63, r32 = lane & 31, hi = lane >> 5;
  char* V_lds = lds; char* K_lds = lds + 2 * SHM_V;
  float* ws = (float*)(lds + 2 * SHM_V + 2 * SHM_K) + wid * 64; float* li_l = ws; float* al_l = ws + 32;
  float m_reg = -1e30f, l_reg = 0; f32x16 o[4] = {}; bf16x8 qr[12];
  const bf16_t* Qw = Qb + (size_t)(wid * QBLK + r32) * LDQ + hi * 8;
#pragma unroll
  for (int d0 = 0; d0 < 12; ++d0) qr[d0] = *(const bf16x8*)(Qw + d0 * 16);
  const int sr = tid >> 4, sc = (tid & 15) * 8, vst0 = v_st(sr, sc), vst1 = v_st(32 + sr, sc);
  const int kc0 = tid, kc1 = tid + 512, kc2 = tid + 1024;
  const int kr0 = kc0 / 24, kr1 = kc1 / 24, kr2 = kc2 / 24, kq0 = (kc0 % 24) * 8, kq1 = (kc1 % 24) * 8, kq2 = (kc2 % 24) * 8;
  const int kst0 = KSWZ(kr0, kq0 * 2), kst1 = KSWZ(kr1, kq1 * 2), kst2 = KSWZ(kr2, kq2 * 2);
  const int kg0 = kr0 * LDK + kq0, kg1 = kr1 * LDK + kq1, kg2 = kr2 * LDK + kq2;
  const int vb0 = (int)(uintptr_t)V_lds + v_rd_base(lane);
  bf16x8 vs0, vs1, ks0, ks1, ks2;
#define SLOAD(k0) do { vs0 = *(const bf16x8*)(Vh + (size_t)((k0) + sr) * LDV + sc); vs1 = *(const bf16x8*)(Vh + (size_t)((k0) + 32 + sr) * LDV + sc); \
    const bf16_t* kp_ = Kh + (size_t)(k0) * LDK; ks0 = *(const bf16x8*)(kp_ + kg0); ks1 = *(const bf16x8*)(kp_ + kg1); ks2 = *(const bf16x8*)(kp_ + kg2); } while (0)
#define SWRITE(b) do { *(bf16x8*)(V_lds + (b) * SHM_V + vst0) = vs0; *(bf16x8*)(V_lds + (b) * SHM_V + vst1) = vs1; \
    *(bf16x8*)(K_lds + (b) * SHM_K + kst0) = ks0; *(bf16x8*)(K_lds + (b) * SHM_K + kst1) = ks1; *(bf16x8*)(K_lds + (b) * SHM_K + kst2) = ks2; } while (0)
#define SWAIT() asm volatile("s_waitcnt vmcnt(0)" ::: "memory")
#define RESC(a) do { if (__any((a) < 1.f)) { if (hi == 0) al_l[r32] = (a); asm volatile("s_waitcnt lgkmcnt(0)" ::: "memory"); \
    _Pragma("unroll") for (int d = 0; d < 4; ++d) _Pragma("unroll") for (int r = 0; r < 16; ++r) o[d][r] *= al_l[crow(r, hi)]; } } while (0)
  f32x16 pA0, pA1, pB0, pB1; float mnA, mnB, alA, alB; bf16x8 pa0, pa1, pa2, pa3; const int NT = seq / KVBLK;
  SLOAD(0); SWAIT(); SWRITE(0); __syncthreads();
  qkt(pA0, pA1, K_lds, qr, r32, hi); partialSM(pA0, pA1, m_reg, mnA, alA);
  SLOAD(KVBLK); SWAIT(); SWRITE(1); __syncthreads();
  for (int j = 1; j + 1 < NT; j += 2) {
    SBAR(); qkt(pB0, pB1, K_lds + SHM_K, qr, r32, hi);
    finishSM(pA0, pA1, alA, l_reg, pa0, pa1, pa2, pa3); SBAR();
    SLOAD((j + 1) * KVBLK); SBAR();
    pv_d0(o, vb0, pa0, pa1, pa2, pa3); partialSM(pB0, pB1, m_reg, mnB, alB);
    __syncthreads(); SWAIT(); SWRITE(0);
    RESC(alB); __syncthreads();
    SBAR(); qkt(pA0, pA1, K_lds, qr, r32, hi);
    finishSM(pB0, pB1, alB, l_reg, pa0, pa1, pa2, pa3); SBAR();
    SLOAD((j + 2) * KVBLK); SBAR();
    pv_d0(o, vb0 + SHM_V, pa0, pa1, pa2, pa3); partialSM(pA0, pA1, m_reg, mnA, alA);
    __syncthreads(); SWAIT(); SWRITE(1);
    RESC(alA); __syncthreads();
  }
  SBAR(); qkt(pB0, pB1, K_lds + SHM_K, qr, r32, hi);
  finishSM(pA0, pA1, alA, l_reg, pa0, pa1, pa2, pa3); SBAR();
  pv_d0(o, vb0, pa0, pa1, pa2, pa3); partialSM(pB0, pB1, m_reg, mnB, alB);
  __syncthreads(); RESC(alB);
  finishSM(pB0, pB1, alB, l_reg, pa0, pa1, pa2, pa3); SBAR();
  pv_d0(o, vb0 + SHM_V, pa0, pa1, pa2, pa3);
  if (hi == 0) li_l[r32] = l_reg; asm volatile("s_waitcnt lgkmcnt(0)" ::: "memory");
  float rli[16];
#pragma unroll
  for (int r = 0; r < 16; ++r) rli[r] = __builtin_amdgcn_rcpf(li_l[crow(r, hi)]);
#pragma unroll
  for (int r = 0; r < 16; ++r) { const int orow = wid * QBLK + crow(r, hi);
#pragma unroll
    for (int d0 = 0; d0 < 4; ++d0) { const float g = bf2f(Gb[(size_t)orow * 512 + d0 * 32 + r32]); Ob[(size_t)orow * 1024 + d0 * 32 + r32] = (bf16_t)f2bf(o[d0][r] * rli[r] * g); } }
  __syncthreads();
#undef SLOAD
#undef SWRITE
#undef SWAIT
#undef RESC
}
}

namespace gla {
constexpr int LS = 72;
constexpr int O_QS = 0, O_KS = 8192, O_LR = 16384, O_TOT = 18432, O_DEC = 20480, O_QIN = 20736, O_KIN = O_QIN + 9216, O_QINTER = O_KIN + 9216, O_KST = O_QINTER + 9216,
              O_AM = O_KST + 9216, O_ST = O_AM + 9216, O_VT = O_ST + 18432, O_OUTS = O_VT + 18432, LDS_END = O_OUTS + 64 * 136 * 2;
__device__ __forceinline__ f32x4 mma16(const bf16_t* Ap, const bf16_t* Bp, f32x4 acc) {
    acc = __builtin_amdgcn_mfma_f32_16x16x32_bf16(*(const bf16x8*)Ap, *(const bf16x8*)Bp, acc, 0, 0, 0);
    acc = __builtin_amdgcn_mfma_f32_16x16x32_bf16(*(const bf16x8*)(Ap + 32), *(const bf16x8*)(Bp + 32), acc, 0, 0, 0);
    return acc;
}
__device__ __forceinline__ void stream(const Params& P, int layer, int sid, char* lds, int wid_s) {
    const int b = sid >> 3, h = (sid >> 1) & 3, dir = sid & 1;
    const int tid = tid_now(wid_s), lane = tid & 63, w = tid >> 6, d = lane, g = w, fr = lane & 15, fq = lane >> 4;
    unsigned char* ws = P.ws;
    const bf16_t* GQ = (const bf16_t*)(ws + WS_GQ) + h * 64; const bf16_t* GK = (const bf16_t*)(ws + WS_GK) + h * 64; const bf16_t* GV = (const bf16_t*)(ws + WS_GV) + h * 128;
    const bf16_t* LR = (const bf16_t*)(ws + WS_LR) + dir * 16;
    bf16_t* OUT = dir ? (bf16_t*)(ws + WS_OB) + h * 128 : (bf16_t*)(ws + WS_Y) + 512 + h * 128; const int ostride = dir ? 512 : 1024;
    float wreg[16];
    { const float* wg = (dir ? P.wgb : P.wgf) + layer * 16 * 256 + h * 64 + d;
#pragma unroll
      for (int r = 0; r < 16; ++r) wreg[r] = wg[r * 256]; }
    const float bias = (dir ? P.bgb : P.bgf)[layer * 256 + h * 64 + d];
    bf16_t* Qs = (bf16_t*)(lds + O_QS); bf16_t* Ks = (bf16_t*)(lds + O_KS); bf16_t* LRs = (bf16_t*)(lds + O_LR); float* TOT = (float*)(lds + O_TOT); float* DEC = (float*)(lds + O_DEC);
    bf16_t* QIN = (bf16_t*)(lds + O_QIN); bf16_t* KIN = (bf16_t*)(lds + O_KIN); bf16_t* QINTER = (bf16_t*)(lds + O_QINTER); bf16_t* KST = (bf16_t*)(lds + O_KST);
    bf16_t* AM = (bf16_t*)(lds + O_AM); bf16_t* ST = (bf16_t*)(lds + O_ST); bf16_t* VT = (bf16_t*)(lds + O_VT); bf16_t* OUTS = (bf16_t*)(lds + O_OUTS);
    f32x4 st[4];
#pragma unroll
    for (int m = 0; m < 4; ++m) st[m] = (f32x4){0.f, 0.f, 0.f, 0.f};
    const int qtok = tid >> 3, qc8 = tid & 7, vtok = tid & 63, vc8 = tid >> 6, ltok = tid >> 1, lhalf = tid & 1;
    const size_t tb = (size_t)b * SEQ;
#define ACT(step, tokp) (tb + (dir ? (63 - (step)) * 64 + (63 - (tokp)) : (step) * 64 + (tokp)))
    bf16x8 rq, rk, rv0, rv1, rl;
#define PREFETCH(step) do { const size_t tq_ = ACT(step, qtok), tv_ = ACT(step, vtok); \
        rq = *(const bf16x8*)(GQ + tq_ * 256 + qc8 * 8); rk = *(const bf16x8*)(GK + tq_ * 256 + qc8 * 8); \
        rv0 = *(const bf16x8*)(GV + tv_ * 512 + vc8 * 8); rv1 = *(const bf16x8*)(GV + tv_ * 512 + 64 + vc8 * 8); \
        if (tid < 128) rl = *(const bf16x8*)(LR + ACT(step, ltok) * 32 + lhalf * 8); } while (0)
    PREFETCH(0);
    for (int step = 0; step < 64; ++step) {
        *(bf16x8*)(Qs + qtok * 64 + qc8 * 8) = rq; *(bf16x8*)(Ks + qtok * 64 + qc8 * 8) = rk;
        if (tid < 128) *(bf16x8*)(LRs + ltok * 16 + lhalf * 8) = rl;
#pragma unroll
        for (int e = 0; e < 8; ++e) { VT[(vc8 * 8 + e) * LS + vtok] = (bf16_t)rv0[e]; VT[(64 + vc8 * 8 + e) * LS + vtok] = (bf16_t)rv1[e]; }
        __syncthreads();
        if (step + 1 < 64) PREFETCH(step + 1);
        float bb[8];
#pragma unroll
        for (int j = 0; j < 8; ++j) { const bf16x8 l0 = *(const bf16x8*)(LRs + (8 * g + j) * 16), l1 = *(const bf16x8*)(LRs + (8 * g + j) * 16 + 8); float z = bias;
#pragma unroll
            for (int r = 0; r < 8; ++r) { z = fmaf(bf2f((unsigned short)l0[r]), wreg[r], z); z = fmaf(bf2f((unsigned short)l1[r]), wreg[8 + r], z); }
            const float ls = fminf(z, 0.f) - __logf(1.f + __expf(-fabsf(z))); bb[j] = ls * (1.f / 16.f); }
#pragma unroll
        for (int j = 1; j < 8; ++j) bb[j] += bb[j - 1];
        TOT[g * 64 + d] = bb[7];
        __syncthreads();
        float pre = 0.f, ref = 0.f, blast = 0.f;
#pragma unroll
        for (int k = 0; k < 8; ++k) { const float t = TOT[k * 64 + d]; if (k < g) pre += t; if (k < 4) ref += t; blast += t; }
        { float kst[8];
#pragma unroll
          for (int j = 0; j < 8; ++j) { const float bj = pre + bb[j]; const int tok = 8 * g + j; const float q = bf2f(Qs[tok * 64 + d]), k = bf2f(Ks[tok * 64 + d]);
              QIN[tok * LS + d] = (bf16_t)f2bf(q * __expf(bj - ref)); KIN[tok * LS + d] = (bf16_t)f2bf(k * __expf(ref - bj)); QINTER[tok * LS + d] = (bf16_t)f2bf(q * __expf(bj));
              kst[j] = k * __expf(blast - bj); }
          u32x4 kw; kw.x = cvt_pk_bf16(kst[0], kst[1]); kw.y = cvt_pk_bf16(kst[2], kst[3]); kw.z = cvt_pk_bf16(kst[4], kst[5]); kw.w = cvt_pk_bf16(kst[6], kst[7]);
          *(u32x4*)(KST + d * LS + 8 * g) = kw; }
        if (g == 0) DEC[d] = __expf(blast);
#pragma unroll
        for (int m = 0; m < 4; ++m) { f32x2 sw; ((unsigned*)&sw)[0] = cvt_pk_bf16(st[m][0], st[m][1]); ((unsigned*)&sw)[1] = cvt_pk_bf16(st[m][2], st[m][3]);
            *(f32x2*)(ST + (16 * w + fr) * LS + 16 * m + 4 * fq) = sw; }
        __syncthreads();
#pragma unroll
        for (int e = 0; e < 2; ++e) { const int tile = 2 * w + e, mi = tile >> 2, nj = tile & 3;
            f32x4 a = mma16(QIN + (16 * mi + fr) * LS + fq * 8, KIN + (16 * nj + fr) * LS + fq * 8, (f32x4){0.f, 0.f, 0.f, 0.f});
#pragma unroll
            for (int jj = 0; jj < 4; ++jj) { const int i = 16 * mi + 4 * fq + jj, j = 16 * nj + fr; AM[i * LS + j] = (bf16_t)f2bf(j <= i ? a[jj] : 0.f); } }
        f32x4 oacc[4];
#pragma unroll
        for (int m = 0; m < 4; ++m) oacc[m] = mma16(QINTER + (16 * m + fr) * LS + fq * 8, ST + (16 * w + fr) * LS + fq * 8, (f32x4){0.f, 0.f, 0.f, 0.f});
#pragma unroll
        for (int m = 0; m < 4; ++m) { const f32x4 dc = *(const f32x4*)(DEC + 16 * m + 4 * fq); st[m] = mma16(KST + (16 * m + fr) * LS + fq * 8, VT + (16 * w + fr) * LS + fq * 8, st[m] * dc); }
        __syncthreads();
#pragma unroll
        for (int m = 0; m < 4; ++m) { oacc[m] = mma16(AM + (16 * m + fr) * LS + fq * 8, VT + (16 * w + fr) * LS + fq * 8, oacc[m]);
#pragma unroll
            for (int jj = 0; jj < 4; ++jj) { const int i = 16 * m + 4 * fq + jj; OUTS[i * 136 + 16 * w + fr] = (bf16_t)f2bf(oacc[m][jj]); } }
        __syncthreads();
#pragma unroll
        for (int q = 0; q < 2; ++q) { const int chunk = tid + q * 512, row = chunk >> 4, c8 = (chunk & 15) * 8;
            *(bf16x8*)(OUT + ACT(step, row) * ostride + c8) = *(const bf16x8*)(OUTS + row * 136 + c8); }
    }
#undef ACT
#undef PREFETCH
}
__device__ __forceinline__ void combine(const Params& P, int layer, int wid_s, int cb, int ncb) {
    unsigned char* ws = P.ws; bf16_t* Y = (bf16_t*)(ws + WS_Y); const bf16_t* OB = (const bf16_t*)(ws + WS_OB); const bf16_t* GG = (const bf16_t*)(ws + WS_GG);
    const int tid = tid_now(wid_s), lane = tid & 63, gw = (cb * 512 + tid) >> 6, nw = (ncb * 512) >> 6, c0 = lane * 8;
    float gn[8];
#pragma unroll
    for (int e = 0; e < 8; ++e) gn[e] = P.gla_norm[layer * 128 + (c0 & 127) + e];
    for (int row = gw; row < T; row += nw) {
        const bf16x8 a = *(const bf16x8*)(Y + (size_t)row * 1024 + 512 + c0), bq = *(const bf16x8*)(OB + (size_t)row * 512 + c0), gg = *(const bf16x8*)(GG + (size_t)row * 512 + c0);
        float v[8]; float ss = 0.f;
#pragma unroll
        for (int e = 0; e < 8; ++e) { v[e] = bf2f((unsigned short)a[e]) + bf2f((unsigned short)bq[e]); ss += v[e] * v[e]; }
        ss += shx(ss, lane, 1); ss += shx(ss, lane, 2); ss += shx(ss, lane, 4); ss += shx(ss, lane, 8);
        const float r = rsqrtf(ss * (1.f / 128.f) + EPS);
#pragma unroll
        for (int e = 0; e < 8; ++e) v[e] = v[e] * r * gn[e] * bf2f((unsigned short)gg[e]);
        u32x4 wv; wv.x = cvt_pk_bf16(v[0], v[1]); wv.y = cvt_pk_bf16(v[2], v[3]); wv.z = cvt_pk_bf16(v[4], v[5]); wv.w = cvt_pk_bf16(v[6], v[7]);
        *(u32x4*)(Y + (size_t)row * 1024 + 512 + c0) = wv;
    }
}
}

constexpr int LDS_BYTES = 131072;
static_assert(att::SHM_ATTN <= LDS_BYTES && gla::LDS_END <= LDS_BYTES && pg8::STAGE_BYTES <= LDS_BYTES, "LDS map");

template <class Epi> __device__ __forceinline__ void run_gemm(unsigned char* lds, const bf16_t* A, const bf16_t* Bt, int N, int K, const Epi& E, int wid_s, int Gov = 0, int cov = 0) {
    pg8::Gemm g; g.A = A; g.Bt = Bt; g.M = T; g.N = N; g.K = K;
    int G_ = Gov ? Gov : (int)gridDim.x, c_ = Gov ? cov : (int)blockIdx.x; asm volatile("" : "+s"(G_), "+s"(c_));
    pg8::StaticOrder S; S.init(T, N, G_, c_);
#ifndef NO_GEMM
    pg8::gemm_phase<Epi, pg8::StaticOrder, true, false>((PG8_LAS unsigned char*)lds, g, S, E, wid_s);
#endif
}

#define KP ((const volatile __attribute__((address_space(4))) Params*)__builtin_amdgcn_kernarg_segment_ptr())
__device__ __forceinline__ Params load_params() {
    Params L; L.x = KP->x; L.p = KP->p; L.pos = KP->pos; L.ln_mix = KP->ln_mix; L.w_in = KP->w_in; L.q_norm = KP->q_norm; L.w_uq = KP->w_uq; L.kv_norm = KP->kv_norm; L.w_ukv = KP->w_ukv;
    L.wgf = KP->wgf; L.bgf = KP->bgf; L.wgb = KP->wgb; L.bgb = KP->bgb; L.gla_norm = KP->gla_norm; L.w_out = KP->w_out; L.ple_norm = KP->ple_norm; L.w_pg = KP->w_pg; L.w_pp = KP->w_pp;
    L.final_norm = KP->final_norm; L.out = KP->out; L.ws = KP->ws; return L;
}

__device__ __forceinline__ void grid_bar(int idx, int wid_s) {
    __syncthreads();
    if (tid_now(wid_s) == 0) {
        unsigned* bar = (unsigned*)(KP->ws + WS_END);
        const unsigned gen = (unsigned)idx * gridDim.x;
        __builtin_amdgcn_fence(__ATOMIC_RELEASE, "agent"); asm volatile("s_waitcnt vmcnt(0)" ::: "memory");
        __hip_atomic_fetch_add(bar, 1u, __ATOMIC_RELAXED, __HIP_MEMORY_SCOPE_AGENT);
        while (__hip_atomic_load(bar, __ATOMIC_RELAXED, __HIP_MEMORY_SCOPE_AGENT) < gen) __builtin_amdgcn_s_sleep(40);
        __builtin_amdgcn_fence(__ATOMIC_ACQUIRE, "agent"); asm volatile("s_waitcnt vmcnt(0)" ::: "memory");
    }
    __syncthreads();
}
__global__ void __launch_bounds__(512, 2) hymba_fwd(Params Punused) {
    extern __shared__ __attribute__((aligned(16))) unsigned char lds[];
    cg::grid_group grid = cg::this_grid();
    const int wid_s = __builtin_amdgcn_readfirstlane(threadIdx.x >> 6);
    { const Params P = load_params(); prologue(P, wid_s, (float*)lds); }
    grid.sync();
    for (int l = 0; l < 2; ++l) {
        {
            unsigned char* ws = KP->ws; unsigned char* wb = ws + WS_W + l * W_LSTRIDE;
            Epi1 E; E.wsb = ws; run_gemm(lds, (const bf16_t*)(ws + WS_XBA), (const bf16_t*)(wb + WO_IN), DINP, 1024, E, wid_s);
        }
        grid_bar(l * 5 + 1, wid_s);
        {
            unsigned char* ws = KP->ws; unsigned char* wb = ws + WS_W + l * W_LSTRIDE;
            EpiQ EQ; EQ.wsb = ws; run_gemm(lds, (const bf16_t*)(ws + WS_CQ), (const bf16_t*)(wb + WO_UQ), 768, 384, EQ, wid_s);
            EpiKV EK; EK.wsb = ws; run_gemm(lds, (const bf16_t*)(ws + WS_CKV), (const bf16_t*)(wb + WO_UKV), 1024, 256, EK, wid_s);
        }
        grid_bar(l * 5 + 2, wid_s);
        {
            int G = gridDim.x, c = blockIdx.x; asm volatile("" : "+s"(G), "+s"(c));
#ifndef NO_GLA
            if (c < 64) {
                const Params P = load_params(); gla::stream(P, l, c, (char*)lds, wid_s);
                __syncthreads();
                if (tid_now(wid_s) == 0) { unsigned* gb = (unsigned*)(P.ws + WS_END + 3072) + l * 16;
                    __builtin_amdgcn_fence(__ATOMIC_RELEASE, "agent"); asm volatile("s_waitcnt vmcnt(0)" ::: "memory"); __hip_atomic_fetch_add(gb, 1u, __ATOMIC_RELAXED, __HIP_MEMORY_SCOPE_AGENT);
                    while (__hip_atomic_load(gb, __ATOMIC_RELAXED, __HIP_MEMORY_SCOPE_AGENT) < 64u) __builtin_amdgcn_s_sleep(24);
                    __builtin_amdgcn_fence(__ATOMIC_ACQUIRE, "agent"); asm volatile("s_waitcnt vmcnt(0)" ::: "memory"); }
                __syncthreads();
                gla::combine(P, l, wid_s, c, 64);
            }
#endif
            __syncthreads();
            if (c >= 64) {
            unsigned char* ws = KP->ws;
            bf16_t* Qb = (bf16_t*)(ws + WS_Q); bf16_t* Kb = (bf16_t*)(ws + WS_K); bf16_t* Vb = (bf16_t*)(ws + WS_V); bf16_t* GA = (bf16_t*)(ws + WS_GA); bf16_t* Y = (bf16_t*)(ws + WS_Y);
            unsigned* qctr = (unsigned*)(ws + WS_END + 256) + l * 8 * 16;
            volatile int* slot = (volatile int*)(lds + 90112);
            const int x0 = c & 7;
            for (int qi = 0; qi < 8; ++qi) { const int xq = (x0 + qi) & 7;
                for (;;) {
                    if (tid_now(wid_s) == 0) *slot = (int)__hip_atomic_fetch_add(qctr + 16 * xq, 1u, __ATOMIC_RELAXED, __HIP_MEMORY_SCOPE_AGENT);
                    __syncthreads();
                    const int u = __builtin_amdgcn_readfirstlane(*slot);
                    __syncthreads();
                    if (u >= 64) break;
                    const int bh = xq * 4 + (u >> 4), qb = u & 15, b = bh >> 2, h = bh & 3; const size_t r0 = (size_t)b * SEQ + qb * 256;
#ifndef NO_ATTN
                    att::attn_unit(Qb + r0 * 768 + h * 192, Kb + (size_t)b * SEQ * 768 + h * 192, Vb + (size_t)b * SEQ * 512 + h * 128, GA + r0 * 512 + h * 128, Y + r0 * 1024 + h * 128, SEQ, (char*)lds, wid_s);
#endif
                }
            }
                { unsigned* pctr = (unsigned*)(ws + WS_END + 3584) + l * 16; const float* psrc = KP->p + (size_t)l * T * 256; bf16_t* PBl = (bf16_t*)(ws + WS_PB) + (size_t)l * T * 256;
                  for (;;) {
                    if (tid_now(wid_s) == 0) *slot = (int)__hip_atomic_fetch_add(pctr, 1u, __ATOMIC_RELAXED, __HIP_MEMORY_SCOPE_AGENT);
                    __syncthreads();
                    const int ch = __builtin_amdgcn_readfirstlane(*slot);
                    __syncthreads();
                    if (ch >= 64) break;
                    const size_t base = (size_t)ch * (T * 256 / 64) + (size_t)tid_now(wid_s) * 8;
#pragma unroll 1
                    for (int it = 0; it < 32; it += 4) { f32x4 a[4], b[4];
#pragma unroll
                        for (int t = 0; t < 4; ++t) { const size_t o = base + (size_t)(it + t) * 4096; a[t] = *(const f32x4*)(psrc + o); b[t] = *(const f32x4*)(psrc + o + 4); }
#pragma unroll
                        for (int t = 0; t < 4; ++t) { const size_t o = base + (size_t)(it + t) * 4096; *(u32x4*)(PBl + o) = pack8(a[t], b[t]); } }
                  } }
                if (l == 0) {
                    unsigned* wctr = (unsigned*)(ws + WS_END + 3840);
                    for (;;) {
                        if (tid_now(wid_s) == 0) *slot = (int)__hip_atomic_fetch_add(wctr, 1u, __ATOMIC_RELAXED, __HIP_MEMORY_SCOPE_AGENT);
                        __syncthreads();
                        const int ch = __builtin_amdgcn_readfirstlane(*slot);
                        __syncthreads();
                        if (ch >= 64) break;
                        const Params P = load_params(); conv_layer_weights(P, 1, (float*)lds, tid_now(wid_s), ch, 64);
                    }
                }
            }
        }
        grid_bar(l * 5 + 3, wid_s);
        {
            unsigned char* ws = KP->ws; unsigned char* wb = ws + WS_W + l * W_LSTRIDE;
            { EpiPP EP; EP.PPd = (bf16_t*)KP->out; run_gemm(lds, (const bf16_t*)(ws + WS_PB) + (size_t)l * T * 256, (const bf16_t*)(wb + WO_PP), 1024, 256, EP, wid_s); }
            EpiOut EO; EO.HIN = l == 0 ? KP->x : nullptr; EO.wsb = ws; run_gemm(lds, (const bf16_t*)(ws + WS_Y), (const bf16_t*)(wb + WO_OUT), 1024, 1024, EO, wid_s);
        }
        grid_bar(l * 5 + 4, wid_s);
        {
            unsigned char* ws = KP->ws; unsigned char* wb = ws + WS_W + l * W_LSTRIDE;
            EpiPle EG; EG.PPd = (const bf16_t*)KP->out; EG.wsb = ws; run_gemm(lds, (const bf16_t*)(ws + WS_XBB), (const bf16_t*)(wb + WO_PG), 1024, 1024, EG, wid_s);
        }
        grid_bar(l * 5 + 5, wid_s);
    }
    {
        const Params P = load_params(); const float* SSA = (const float*)(P.ws + WS_SSA); const bf16_t* XA = (const bf16_t*)(P.ws + WS_XBA);
        const int tid = tid_now(wid_s), lane = tid & 63, gw = (blockIdx.x * 512 + tid) >> 6, nw = (gridDim.x * 512) >> 6;
        f32x4 gn[4];
#pragma unroll
        for (int it = 0; it < 4; ++it) gn[it] = *(const f32x4*)(P.final_norm + it * 256 + lane * 4);
        for (int row = gw; row < T; row += nw) { float s = SSA[(size_t)row * 16 + (lane & 15)];
            s += shx(s, lane, 1); s += shx(s, lane, 2); s += shx(s, lane, 4); s += shx(s, lane, 8); const float r = rsqrtf(s * (1.f / 1024.f) + EPS);
#pragma unroll
            for (int it = 0; it < 4; ++it) { const size_t o = (size_t)row * 1024 + it * 256 + lane * 4; const f32x2 w = *(const f32x2*)(XA + o); const unsigned w0 = ((const unsigned*)&w)[0], w1 = ((const unsigned*)&w)[1];
                f32x4 v; v[0] = __builtin_bit_cast(float, w0 << 16); v[1] = __builtin_bit_cast(float, w0 & 0xffff0000u); v[2] = __builtin_bit_cast(float, w1 << 16); v[3] = __builtin_bit_cast(float, w1 & 0xffff0000u);
                *(f32x4*)(P.out + o) = v * r * gn[it]; } }
    }
}

extern "C" void kernel_launch(void* const* d_in, const int* in_sizes, int n_in, void* d_out, int out_size, void* d_ws, size_t ws_size, hipStream_t stream) {
    static int grid_blocks = 0;
    if (n_in != 19 || ws_size < WS_END + 4096) { fprintf(stderr, "kernel_launch: unexpected inputs (n_in %d, ws %zu)\n", n_in, ws_size); return; }
    if (!grid_blocks) {
        if (hipFuncSetAttribute((const void*)hymba_fwd, hipFuncAttributeMaxDynamicSharedMemorySize, LDS_BYTES) != hipSuccess) { fprintf(stderr, "hipFuncSetAttribute failed\n"); return; }
        int dev = 0, cus = 0, per_cu = 0; hipGetDevice(&dev); hipDeviceGetAttribute(&cus, hipDeviceAttributeMultiprocessorCount, dev);
        if (hipOccupancyMaxActiveBlocksPerMultiprocessor(&per_cu, (const void*)hymba_fwd, 512, LDS_BYTES) != hipSuccess || per_cu < 1) { fprintf(stderr, "occupancy query failed\n"); return; }
        grid_blocks = cus;
    }
    Params P{};
    P.x = (const float*)d_in[0]; P.p = (const float*)d_in[1]; P.pos = (const int*)d_in[2]; P.ln_mix = (const float*)d_in[3]; P.w_in = (const float*)d_in[4]; P.q_norm = (const float*)d_in[5];
    P.w_uq = (const float*)d_in[6]; P.kv_norm = (const float*)d_in[7]; P.w_ukv = (const float*)d_in[8]; P.wgf = (const float*)d_in[9]; P.bgf = (const float*)d_in[10]; P.wgb = (const float*)d_in[11];
    P.bgb = (const float*)d_in[12]; P.gla_norm = (const float*)d_in[13]; P.w_out = (const float*)d_in[14]; P.ple_norm = (const float*)d_in[15]; P.w_pg = (const float*)d_in[16]; P.w_pp = (const float*)d_in[17];
    P.final_norm = (const float*)d_in[18]; P.out = (float*)d_out; P.ws = (unsigned char*)d_ws;
    if (hipMemsetAsync((char*)d_ws + WS_END, 0, 4096, stream) != hipSuccess) { fprintf(stderr, "memset failed\n"); return; }
    void* args[] = {&P};
    hipError_t e = hipLaunchCooperativeKernel((const void*)hymba_fwd, dim3(grid_blocks), dim3(512), args, LDS_BYTES, stream);
    if (e != hipSuccess) fprintf(stderr, "cooperative launch failed: %s (grid %d)\n", hipGetErrorString(e), grid_blocks);
}
```
